# Optimizing an MI355X kernel written in HIP

```python
import math
import jax, jax.numpy as jnp
from jax import lax
import numpy as np

D_MODEL = 1024
BATCH = 4
SEQ = 8192
DEPTH = 4

CONV_WIDTH = D_MODEL // 2
CONV_K = 3
RWKV_WIDTH = D_MODEL - CONV_WIDTH
HEAD_SIZE = 64
RWKV_HEADS = RWKV_WIDTH // HEAD_SIZE
D_DECAY_LORA = 64
D_AAA_LORA = 64
D_GATE_LORA = 128
D_FF = -(-8 * D_MODEL // (3 * 256)) * 256
N_MOD = 6
DEEPNORM_ALPHA = (2.0 * DEPTH) ** 0.25
DEEPNORM_BETA = (8.0 * DEPTH) ** -0.25
LN_EPS = 1e-5
GN_EPS = 64e-5

N_CONV_COLS = 3 * CONV_WIDTH
N_SHIFT_COLS = 3 * RWKV_WIDTH + D_DECAY_LORA + D_AAA_LORA + D_GATE_LORA
N_IN_COLS = N_CONV_COLS + N_SHIFT_COLS

kernel_name = "hymba_conv_rwkv7_deepnorm_adaln"


def layer_norm(x, g, b):
    xf = x.astype(jnp.float32)
    mu = jnp.mean(xf, axis=-1, keepdims=True)
    var = jnp.mean(jnp.square(xf - mu), axis=-1, keepdims=True)
    y = (xf - mu) * lax.rsqrt(var + LN_EPS)
    return (y * g.astype(jnp.float32) + b.astype(jnp.float32)).astype(x.dtype)


def token_shift(p):
    return jnp.pad(p, ((0, 0), (1, 0), (0, 0)))[:, :-1, :]


def heads(t):
    return t.reshape(t.shape[:-1] + (RWKV_HEADS, HEAD_SIZE))


def short_conv_mixer(p_conv, conv_w):
    b_gate, c_gate, u = jnp.split(p_conv, 3, axis=-1)
    z = c_gate * u
    zc = lax.conv_general_dilated(
        z, conv_w.astype(z.dtype)[:, None, :], window_strides=(1,),
        padding=[(CONV_K - 1, 0)],
        dimension_numbers=('NWC', 'WIO', 'NWC'),
        feature_group_count=CONV_WIDTH)
    return b_gate * zc


def rwkv7_scan(r, decay, k, v, a_vec, b_vec):
    def step(state, inp):
        r_t, w_t, k_t, v_t, a_t, b_t = inp
        sa = jnp.einsum('bhvk,bhk->bhv', state, a_t)
        state = (state * w_t[:, :, None, :]
                 + sa[..., None] * b_t[:, :, None, :]
                 + v_t[..., None] * k_t[:, :, None, :])
        y_t = jnp.einsum('bhvk,bhk->bhv', state, r_t)
        return state, y_t
    xs = tuple(jnp.moveaxis(t, 1, 0) for t in (r, decay, k, v, a_vec, b_vec))
    bsz = r.shape[0]
    s0 = jnp.zeros((bsz, RWKV_HEADS, HEAD_SIZE, HEAD_SIZE), jnp.float32)
    _, ys = lax.scan(step, s0, xs)
    return jnp.moveaxis(ys, 0, 1)


def rwkv7_mixer(p_shift, mu_shift, w0, w_decay_up, a0, a_up, g_up, k_k, k_a, r_k, lnx_g, lnx_b):
    p = p_shift + mu_shift * (token_shift(p_shift) - p_shift)
    i1 = RWKV_WIDTH
    i2 = 2 * RWKV_WIDTH
    i3 = 3 * RWKV_WIDTH
    i4 = i3 + D_DECAY_LORA
    i5 = i4 + D_AAA_LORA
    r, k, v, w_lo, a_lo, g_lo = jnp.split(p, [i1, i2, i3, i4, i5], axis=-1)
    w_log = -jax.nn.softplus(-(w0 + jnp.tanh(w_lo) @ w_decay_up)) - 0.5
    decay = jnp.exp(-jnp.exp(w_log.astype(jnp.float32)))
    a = jax.nn.sigmoid(a0 + a_lo @ a_up)
    g = jax.nn.sigmoid(g_lo) @ g_up
    kk = heads((k * k_k).astype(jnp.float32))
    kk = kk * lax.rsqrt(jnp.maximum(jnp.sum(jnp.square(kk), -1, keepdims=True), 1e-24))
    k = k * (1.0 + (a - 1.0) * k_a)
    rh = heads(r).astype(jnp.float32)
    kh = heads(k).astype(jnp.float32)
    vh = heads(v).astype(jnp.float32)
    ah = heads(a).astype(jnp.float32)
    y = rwkv7_scan(rh, heads(decay), kh, vh, -kk, kk * ah)
    mu = jnp.mean(y, -1, keepdims=True)
    var = jnp.mean(jnp.square(y - mu), -1, keepdims=True)
    yn = (y - mu) * lax.rsqrt(var + GN_EPS)
    yn = yn.reshape(y.shape[:-2] + (RWKV_WIDTH,)) * lnx_g + lnx_b
    bonus = jnp.sum(rh * kh * r_k.astype(jnp.float32), -1, keepdims=True) * vh
    out = yn + bonus.reshape(y.shape[:-2] + (RWKV_WIDTH,))
    return (out * g).astype(p_shift.dtype)


def setup_inputs(seed: int = 0) -> dict:
    key = jax.random.key(seed)
    ks = jax.random.split(key, 24)

    def nrm(k, shape, scale):
        return jax.random.normal(k, shape, jnp.float32) * scale

    L, D = DEPTH, D_MODEL
    return {
        "x": nrm(ks[0], (BATCH, SEQ, D), 1.0),
        "c": nrm(ks[1], (BATCH, D), 1.0),
        "w_mod": nrm(ks[2], (L, D, N_MOD * D), 0.1 * D ** -0.5),
        "b_mod": nrm(ks[3], (L, N_MOD * D), 0.02),
        "w_in": nrm(ks[4], (L, D, N_IN_COLS), D ** -0.5),
        "conv_w": nrm(ks[5], (L, CONV_K, CONV_WIDTH), CONV_K ** -0.5),
        "mu_shift": jax.random.uniform(ks[6], (L, N_SHIFT_COLS), jnp.float32),
        "w0": jax.random.uniform(ks[7], (L, RWKV_WIDTH), jnp.float32, -5.0, -1.0),
        "w_decay_up": nrm(ks[8], (L, D_DECAY_LORA, RWKV_WIDTH), 0.1 * D_DECAY_LORA ** -0.5),
        "a0": nrm(ks[9], (L, RWKV_WIDTH), 0.1),
        "a_up": nrm(ks[10], (L, D_AAA_LORA, RWKV_WIDTH), 0.1 * D_AAA_LORA ** -0.5),
        "g_up": nrm(ks[11], (L, D_GATE_LORA, RWKV_WIDTH), D_GATE_LORA ** -0.5),
        "k_k": 0.85 + nrm(ks[12], (L, RWKV_WIDTH), 0.02),
        "k_a": 1.0 + nrm(ks[13], (L, RWKV_WIDTH), 0.02),
        "r_k": nrm(ks[14], (L, RWKV_HEADS, HEAD_SIZE), 0.1),
        "lnx_g": 1.0 + nrm(ks[15], (L, RWKV_WIDTH), 0.02),
        "lnx_b": nrm(ks[16], (L, RWKV_WIDTH), 0.02),
        "w_out": nrm(ks[17], (L, D, D), DEEPNORM_BETA * D ** -0.5),
        "ln1_g": 1.0 + nrm(ks[18], (L, D), 0.02),
        "ln1_b": nrm(ks[19], (L, D), 0.02),
        "w_ffn_in": nrm(ks[20], (L, D, 2 * D_FF), D ** -0.5),
        "w_ffn_out": nrm(ks[21], (L, D_FF, D), DEEPNORM_BETA * D_FF ** -0.5),
        "ln2_g": 1.0 + nrm(ks[22], (L, D), 0.02),
        "ln2_b": nrm(ks[23], (L, D), 0.02),
    }


def reference(x, c, w_mod, b_mod, w_in, conv_w, mu_shift, w0, w_decay_up, a0, a_up, g_up,
              k_k, k_a, r_k, lnx_g, lnx_b, w_out, ln1_g, ln1_b, w_ffn_in, w_ffn_out,
              ln2_g, ln2_b):
    silu_c = jax.nn.silu(c)
    for l in range(DEPTH):
        mod = silu_c @ w_mod[l] + b_mod[l]
        sh1, sc1, gt1, sh2, sc2, gt2 = [m[:, None, :] for m in jnp.split(mod, N_MOD, axis=-1)]

        h = x * (1.0 + sc1) + sh1
        p = h @ w_in[l]
        y_conv = short_conv_mixer(p[..., :N_CONV_COLS], conv_w[l])
        y_rwkv = rwkv7_mixer(p[..., N_CONV_COLS:], mu_shift[l], w0[l], w_decay_up[l], a0[l],
                             a_up[l], g_up[l], k_k[l], k_a[l], r_k[l], lnx_g[l], lnx_b[l])
        mix = jnp.concatenate([y_conv, y_rwkv], axis=-1) @ w_out[l]
        x = layer_norm(DEEPNORM_ALPHA * x + (1.0 + gt1) * mix, ln1_g[l], ln1_b[l])

        h = x * (1.0 + sc2) + sh2
        gate, up = jnp.split(h @ w_ffn_in[l], 2, axis=-1)
        f = (jax.nn.silu(gate) * up) @ w_ffn_out[l]
        x = layer_norm(DEEPNORM_ALPHA * x + (1.0 + gt2) * f, ln2_g[l], ln2_b[l])
    return x
```

```cpp
#include <hip/hip_runtime.h>
#include <hip/hip_cooperative_groups.h>
#include <cstdio>
#include <cstdint>
namespace cg = cooperative_groups;
namespace pg8 {
#define PG8_LAS __attribute__((address_space(3)))
typedef unsigned short bf16_t;
typedef short bf16x8 __attribute__((ext_vector_type(8)));
typedef float f32x4 __attribute__((ext_vector_type(4)));
typedef unsigned u32x4 __attribute__((ext_vector_type(4)));
constexpr int BM = 256, BK = 64, HALF = 128, HTB = HALF * BK * 2  , STAGE_BYTES = 8 * HTB, NXCD = 8, WGM = 8;

__host__ __device__ __forceinline__ int lds_byte(int r, int c) { const int st = (r >> 4) * 2 + (c >> 5), rr = r & 15, cc = c & 31, ob = rr * 64 + cc * 2; return st * 1024 + (ob ^ (((ob >> 9) & 1) << 5)); }
__host__ __device__ __forceinline__ void stage_rc(int b, int& R, int& C) { const int st = b / 1024, sb = b % 1024, swz = sb ^ (((sb >> 9) & 1) << 5); R = (st >> 1) * 16 + swz / 64; C = (st & 1) * 32 + (swz % 64) / 2; }
__host__ __device__ __forceinline__ int perm32(int rho) { const int n = rho >> 4, i = rho & 15; return 8 * (i >> 2) + 4 * n + (i & 3); }

struct Unit { int pm, pn; };
struct Gemm { const bf16_t* A; const bf16_t* Bt; int M, N, K; };

struct StaticOrder {
    int nM, nN, nwg, G, c;
    __host__ __device__ void init(int M, int N, int G_, int c_) { nM = M / BM; nN = N / BM; nwg = nM * nN; G = G_; c = c_; }
    __host__ __device__ bool next(int i, Unit& u) const {
        const long L = (long)i * G + c; if (L >= nwg) return false;
        int wgid = (int)L; { const int q = nwg / NXCD, r = nwg % NXCD, xcd = wgid % NXCD, off = wgid / NXCD; wgid = (xcd < r ? xcd * (q + 1) : r * (q + 1) + (xcd - r) * q) + off; }
        const int nig = WGM * nN, gid = wgid / nig, fm = gid * WGM, gsz = (nM - fm) < WGM ? (nM - fm) : WGM;
        u.pm = fm + ((wgid % nig) % gsz); u.pn = (wgid % nig) / gsz; return true;
    }
    __device__ __forceinline__ void a_ready(const Unit&) const {}
    __device__ __forceinline__ void done(const Unit&) const {}
};

__device__ __forceinline__ unsigned cvt_pk_bf16(float lo, float hi) { unsigned r; asm volatile("v_cvt_pk_bf16_f32 %0, %1, %2" : "=v"(r) : "v"(lo), "v"(hi)); return r; }
struct EpiBf16 {
    static constexpr bool PERM = true, AFTER_DRAIN = false;
    bf16_t* O; int ldc;
    __device__ __forceinline__ void operator()(const f32x4 (&acc)[2][2][4][2], const Unit& u, int wr, int wc, int fr, int fq) const {
        const int row0 = u.pm * BM + wr * 64 + fr; const int col0 = u.pn * BM + wc * 32 + 8 * fq;
#pragma unroll
        for (int ai = 0; ai < 2; ++ai)
#pragma unroll
            for (int m = 0; m < 4; ++m) { bf16_t* rowp = O + (size_t)(row0 + ai * HALF + m * 16) * ldc + col0;
#pragma unroll
                for (int bj = 0; bj < 2; ++bj) { const f32x4 v0 = acc[ai][bj][m][0], v1 = acc[ai][bj][m][1];
                    u32x4 w; w.x = cvt_pk_bf16(v0[0], v0[1]); w.y = cvt_pk_bf16(v0[2], v0[3]); w.z = cvt_pk_bf16(v1[0], v1[1]); w.w = cvt_pk_bf16(v1[2], v1[3]);
                    *(u32x4*)(rowp + bj * HALF) = w; } }
    }
};
struct EpiRes {
    static constexpr bool PERM = true, AFTER_DRAIN = false;
    const float* xsrc; float* zdst; const float* gt; float alpha; const float* stats; const float* lng; const float* lnb;
    __device__ __forceinline__ void operator()(const f32x4 (&acc)[2][2][4][2], const Unit& u, int wr, int wc, int fr, int fq) const {
        typedef float f32x2e __attribute__((ext_vector_type(2)));
        const int row0 = u.pm * BM + wr * 64 + fr; const int col0 = u.pn * BM + wc * 32 + 8 * fq;
        const float* gtb = gt + (size_t)(u.pm >> 5) * 6144 + col0;
        const bool ln = stats != nullptr;
#pragma unroll
        for (int bj = 0; bj < 2; ++bj)
#pragma unroll
            for (int n = 0; n < 2; ++n) {
                const int co = bj * HALF + 4 * n;
                const f32x4 g = *(const f32x4*)(gtb + co) + 1.0f;
                f32x4 lg = {1.f, 1.f, 1.f, 1.f}, lb = {0.f, 0.f, 0.f, 0.f};
                if (ln) { lg = *(const f32x4*)(lng + col0 + co); lb = *(const f32x4*)(lnb + col0 + co); }
#pragma unroll
                for (int ai = 0; ai < 2; ++ai)
#pragma unroll
                    for (int m = 0; m < 4; ++m) { const int r = row0 + ai * HALF + m * 16; const size_t o = (size_t)r * 1024 + col0 + co;
                        f32x4 xv = *(const f32x4*)(xsrc + o);
                        if (ln) { const f32x2e st = *(const f32x2e*)(stats + 2 * (size_t)r); xv = (xv - st.x) * st.y * lg + lb; }
                        *(f32x4*)(zdst + o) = xv * alpha + g * acc[ai][bj][m][n]; }
            }
    }
};
struct EpiSwiGLU {
    static constexpr bool PERM = true, AFTER_DRAIN = false;
    bf16_t* O; int ldc;
    __device__ __forceinline__ void operator()(const f32x4 (&acc)[2][2][4][2], const Unit& u, int wr, int wc, int fr, int fq) const {
        const int row0 = u.pm * BM + wr * 64 + fr; const int col0 = u.pn * HALF + wc * 32 + 8 * fq;
#pragma unroll
        for (int ai = 0; ai < 2; ++ai)
#pragma unroll
            for (int m = 0; m < 4; ++m) { bf16_t* rowp = O + (size_t)(row0 + ai * HALF + m * 16) * ldc + col0;
                float r[8];
#pragma unroll
                for (int n = 0; n < 2; ++n)
#pragma unroll
                    for (int i = 0; i < 4; ++i) { const float gv = acc[ai][0][m][n][i], uv = acc[ai][1][m][n][i];
                        r[4 * n + i] = gv * __builtin_amdgcn_rcpf(1.0f + __expf(-gv)) * uv; }
                u32x4 w; w.x = cvt_pk_bf16(r[0], r[1]); w.y = cvt_pk_bf16(r[2], r[3]); w.z = cvt_pk_bf16(r[4], r[5]); w.w = cvt_pk_bf16(r[6], r[7]);
                *(u32x4*)rowp = w; }
    }
};

template <class Epi, class Sched, bool ALIGN_EPI = false, bool SP2 = false>
__device__ __forceinline__ void gemm_phase(PG8_LAS unsigned char* lds, const Gemm g, const Sched& S, const Epi& E) {
    int tid_ = threadIdx.x; asm volatile("" : "+v"(tid_));
    const int tid = tid_, wid = __builtin_amdgcn_readfirstlane(tid >> 6), lane = tid & 63, wr = wid >> 2, wc = wid & 3, fr = lane & 15, fq = lane >> 4;
    int K_ = g.K; asm volatile("" : "+s"(K_));
    const int K = K_, nt = K / BK;
    unsigned voffA[2], voffB[2];
#pragma unroll
    for (int i = 0; i < 2; ++i) { int R, C; stage_rc(tid * 16 + i * 8192, R, C); const int Rb = Epi::PERM ? ((R & ~31) + perm32(R & 31)) : R;
        voffA[i] = (unsigned)(R * K + C) * 2u; voffB[i] = (unsigned)(Rb * K + C) * 2u; }
    const size_t kstep = (size_t)(BK * 2);
    const size_t hstep = (size_t)HALF * K * 2;
    const size_t tstep = 2 * hstep;
    const unsigned ldsw = (unsigned)wid * 1024u;
    const int aoff = lds_byte(wr * 64 + fr, fq * 8), boff = lds_byte(wc * 32 + fr, fq * 8);
#define PG8_SA(b, h) (((b) * 2 + (h)) * HTB)
#define PG8_SB(b, h) ((4 + (b) * 2 + (h)) * HTB)
#define PG8_STAGE(bufoff, gbase, voff) do { _Pragma("unroll") for (int _i = 0; _i < 2; ++_i) \
        __builtin_amdgcn_global_load_lds((const unsigned*)((const char*)(gbase) + (voff)[_i]), (PG8_LAS unsigned*)(lds + (bufoff) + ldsw + _i * 8192), 16, 0, 0); } while (0)
#define PG8_LDA(dst, b, h) do { _Pragma("unroll") for (int m = 0; m < 4; ++m) _Pragma("unroll") for (int k = 0; k < 2; ++k) dst[m][k] = *(const PG8_LAS bf16x8*)(lds + PG8_SA(b, h) + aoff + m * 2048 + k * 1024); } while (0)
#define PG8_LDB(dst, b, h) do { _Pragma("unroll") for (int n = 0; n < 2; ++n) _Pragma("unroll") for (int k = 0; k < 2; ++k) dst[n][k] = *(const PG8_LAS bf16x8*)(lds + PG8_SB(b, h) + boff + n * 2048 + k * 1024); } while (0)
#define PG8_MMA(ai, bj, At, Bt) do { __builtin_amdgcn_s_setprio(1); _Pragma("unroll") for (int m = 0; m < 4; ++m) _Pragma("unroll") for (int n = 0; n < 2; ++n) _Pragma("unroll") for (int k = 0; k < 2; ++k) \
        acc[ai][bj][m][n] = __builtin_amdgcn_mfma_f32_16x16x32_bf16(Bt[n][k], At[m][k], acc[ai][bj][m][n], 0, 0, 0); __builtin_amdgcn_s_setprio(0); } while (0)
#define PG8_WAIT_V(n) asm volatile("s_waitcnt vmcnt(" #n ")" ::: "memory")
#define PG8_WAIT_L(n) asm volatile("s_waitcnt lgkmcnt(" #n ")" ::: "memory")
#define PG8_BAR __builtin_amdgcn_s_barrier()
#define PG8_SCHED __builtin_amdgcn_sched_barrier(0)
    Unit cur, nxt; int ui = 0;
    if (!S.next(0, cur)) return;
    f32x4 acc[2][2][4][2];
#pragma unroll
    for (int a = 0; a < 2; ++a)
#pragma unroll
        for (int b = 0; b < 2; ++b)
#pragma unroll
            for (int m = 0; m < 4; ++m)
#pragma unroll
                for (int n = 0; n < 2; ++n) acc[a][b][m][n] = (f32x4){0.f, 0.f, 0.f, 0.f};
    bf16x8 At[4][2], B0[2][2], B1[2][2];
    const char* cA = (const char*)g.A + (size_t)cur.pm * tstep; const char* cB = (const char*)g.Bt + (size_t)cur.pn * tstep;
    S.a_ready(cur);
    if constexpr (SP2) {
        PG8_STAGE(PG8_SB(0, 0), cB, voffB); PG8_STAGE(PG8_SB(0, 1), cB + hstep, voffB); PG8_STAGE(PG8_SA(0, 0), cA, voffA); PG8_STAGE(PG8_SA(0, 1), cA + hstep, voffA);
        if (wr == 1) PG8_BAR;
        PG8_WAIT_V(2); PG8_BAR;
        PG8_STAGE(PG8_SB(1, 0), cB + kstep, voffB); PG8_STAGE(PG8_SA(1, 0), cA + kstep, voffA); PG8_STAGE(PG8_SB(1, 1), cB + hstep + kstep, voffB);
        PG8_WAIT_V(6); PG8_BAR;
    } else {
        PG8_STAGE(PG8_SB(0, 0), cB, voffB); PG8_STAGE(PG8_SA(0, 0), cA, voffA); PG8_STAGE(PG8_SB(0, 1), cB + hstep, voffB); PG8_STAGE(PG8_SA(0, 1), cA + hstep, voffA);
        if (wr == 1) PG8_BAR;
        PG8_WAIT_V(4); PG8_BAR;
        PG8_STAGE(PG8_SB(1, 0), cB + kstep, voffB); PG8_STAGE(PG8_SA(1, 0), cA + kstep, voffA); PG8_STAGE(PG8_SB(1, 1), cB + hstep + kstep, voffB);
        PG8_WAIT_V(6); PG8_BAR;
    }
    for (;;) {
        const bool has_next = S.next(ui + 1, nxt);
        const char* nA = has_next ? (const char*)g.A + (size_t)nxt.pm * tstep : cA; const char* nB = has_next ? (const char*)g.Bt + (size_t)nxt.pn * tstep : cB;
        for (int t = 0; t < nt; t += 2) {
            const bool last = (t == nt - 2);
            const char* a1 = cA + (size_t)(t + 1) * kstep;
            const char* a2 = last ? nA : cA + (size_t)(t + 2) * kstep; const char* b2 = last ? nB : cB + (size_t)(t + 2) * kstep;
            const char* a3 = a2 + kstep; const char* b3 = b2 + kstep;
            if (last && has_next) S.a_ready(nxt);
            if constexpr (SP2) {
            PG8_LDB(B0, 0, 0); PG8_LDB(B1, 0, 1); PG8_SCHED; PG8_LDA(At, 0, 0); PG8_STAGE(PG8_SA(1, 1), a1 + hstep, voffA);
            PG8_WAIT_V(8); PG8_WAIT_L(0); PG8_BAR; PG8_MMA(0, 0, At, B0); PG8_MMA(0, 1, At, B1); PG8_BAR; PG8_SCHED;
            PG8_LDA(At, 0, 1); PG8_STAGE(PG8_SB(0, 0), b2, voffB); PG8_STAGE(PG8_SB(0, 1), b2 + hstep, voffB); PG8_STAGE(PG8_SA(0, 0), a2, voffA);
            PG8_WAIT_V(8); PG8_WAIT_L(0); PG8_BAR; PG8_MMA(1, 0, At, B0); PG8_MMA(1, 1, At, B1); PG8_BAR; PG8_SCHED;
            PG8_LDB(B0, 1, 0); PG8_LDB(B1, 1, 1); PG8_SCHED; PG8_LDA(At, 1, 0); PG8_STAGE(PG8_SA(0, 1), a2 + hstep, voffA);
            PG8_WAIT_V(8); PG8_WAIT_L(0); PG8_BAR; PG8_MMA(0, 0, At, B0); PG8_MMA(0, 1, At, B1); PG8_BAR; PG8_SCHED;
            PG8_LDA(At, 1, 1); PG8_STAGE(PG8_SB(1, 0), b3, voffB); PG8_STAGE(PG8_SB(1, 1), b3 + hstep, voffB); PG8_STAGE(PG8_SA(1, 0), a3, voffA);
            PG8_WAIT_V(8); PG8_WAIT_L(0); PG8_BAR; PG8_MMA(1, 0, At, B0); PG8_MMA(1, 1, At, B1); PG8_BAR; PG8_SCHED;
            } else {
            PG8_LDB(B0, 0, 0); PG8_SCHED; PG8_LDA(At, 0, 0); PG8_STAGE(PG8_SA(1, 1), a1 + hstep, voffA);
            PG8_WAIT_L(8); PG8_BAR; PG8_WAIT_L(0); PG8_MMA(0, 0, At, B0); PG8_BAR; PG8_SCHED;
            PG8_LDB(B1, 0, 1); PG8_STAGE(PG8_SB(0, 0), b2, voffB);
            PG8_BAR; PG8_WAIT_L(0); PG8_MMA(0, 1, At, B1); PG8_BAR;
            PG8_LDA(At, 0, 1); PG8_STAGE(PG8_SA(0, 0), a2, voffA);
            PG8_BAR; PG8_WAIT_L(0); PG8_MMA(1, 0, At, B0); PG8_BAR; PG8_SCHED;
            PG8_STAGE(PG8_SB(0, 1), b2 + hstep, voffB);
            PG8_WAIT_V(6); PG8_BAR; PG8_MMA(1, 1, At, B1); PG8_BAR;
            PG8_LDB(B0, 1, 0); PG8_SCHED; PG8_LDA(At, 1, 0); PG8_STAGE(PG8_SA(0, 1), a2 + hstep, voffA);
            PG8_WAIT_L(8); PG8_BAR; PG8_WAIT_L(0); PG8_MMA(0, 0, At, B0); PG8_BAR; PG8_SCHED;
            PG8_LDB(B1, 1, 1); PG8_STAGE(PG8_SB(1, 0), b3, voffB);
            PG8_BAR; PG8_WAIT_L(0); PG8_MMA(0, 1, At, B1); PG8_BAR;
            PG8_LDA(At, 1, 1); PG8_STAGE(PG8_SA(1, 0), a3, voffA);
            PG8_BAR; PG8_WAIT_L(0); PG8_MMA(1, 0, At, B0); PG8_BAR; PG8_SCHED;
            PG8_STAGE(PG8_SB(1, 1), b3 + hstep, voffB);
            PG8_WAIT_V(6); PG8_BAR; PG8_MMA(1, 1, At, B1); PG8_BAR;
            }
        }
        if constexpr (ALIGN_EPI) { if (wr == 0) PG8_BAR; }
        if constexpr (!Epi::AFTER_DRAIN) { E(acc, cur, wr, wc, fr, fq); S.done(cur); }
        if (!has_next) break;
#pragma unroll
        for (int a = 0; a < 2; ++a)
#pragma unroll
            for (int b = 0; b < 2; ++b)
#pragma unroll
                for (int m = 0; m < 4; ++m)
#pragma unroll
                    for (int n = 0; n < 2; ++n) acc[a][b][m][n] = (f32x4){0.f, 0.f, 0.f, 0.f};
        cur = nxt; cA = nA; cB = nB; ++ui;
        if constexpr (ALIGN_EPI) { if (wr == 1) PG8_BAR; }
    }
    PG8_WAIT_V(0);
    if constexpr (!ALIGN_EPI) { if (wr == 0) PG8_BAR; }
    PG8_BAR;
    if constexpr (Epi::AFTER_DRAIN) { E.fused(acc, cur, wr, wc, fr, fq, lds, wid, lane); S.done(cur); }
#undef PG8_SA
#undef PG8_SB
#undef PG8_STAGE
#undef PG8_LDA
#undef PG8_LDB
#undef PG8_MMA
#undef PG8_WAIT_V
#undef PG8_WAIT_L
#undef PG8_BAR
#undef PG8_SCHED
}
}
constexpr int BATCH = 4, SEQ = 8192, D = 1024, DEPTH = 4, M = BATCH * SEQ;
constexpr int HS = 64, NH = 8, DFF = 2816, NIN = 3328, SHIFT0 = 1536, NLK = 256, NLN = 1536, NMOD = 6144;
constexpr float ALPHA = 1.681792830507429f;
constexpr float LN_EPS = 1e-5f, GN_EPS = 64e-5f;
constexpr int NWAVES = 8, NTHR = 512, LDS_BYTES = 147456;
constexpr size_t MiB = 1u << 20;
constexpr size_t WS_STATS = 1 * MiB + 512 * 1024;
constexpr size_t WS_MOD = 1 * MiB;
constexpr size_t WS_W = 2 * MiB, W_LAYER = 25 * MiB + 768 * 1024;
constexpr size_t WO_IN = 0, WO_LORA = 6 * MiB + 512 * 1024, WO_OUT = WO_LORA + 768 * 1024, WO_FI = WO_OUT + 2 * MiB, WO_FO = WO_FI + 11 * MiB;
constexpr size_t WS_H = 106 * MiB;
constexpr size_t WS_LORA = 106 * MiB;
constexpr size_t WS_MIX = 202 * MiB;
constexpr size_t WS_P = 266 * MiB;
constexpr size_t WS_ACT = 474 * MiB;
constexpr size_t WS_END = 490 * MiB;
static_assert(WO_FO + (size_t)D * DFF * 2 == W_LAYER && WS_W + DEPTH * W_LAYER <= WS_H && WS_LORA + (size_t)M * NLN * 2 <= WS_MIX && WS_P + (size_t)M * NIN * 2 <= WS_ACT, "ws map");

typedef unsigned short bf16;
typedef float f32x4 __attribute__((ext_vector_type(4)));
typedef unsigned u32x4 __attribute__((ext_vector_type(4)));
typedef unsigned u32x2 __attribute__((ext_vector_type(2)));
#define LAS __attribute__((address_space(3)))
__device__ __forceinline__ unsigned f2bf(float f) { unsigned u = __builtin_bit_cast(unsigned, f); return (u + 0x7fffu + ((u >> 16) & 1u)) >> 16; }
__device__ __forceinline__ unsigned pk2(float lo, float hi) { return f2bf(lo) | (f2bf(hi) << 16); }
__device__ __forceinline__ float bf2f(unsigned short v) { return __builtin_bit_cast(float, (unsigned)v << 16); }
__device__ __forceinline__ float bflo(unsigned w) { return __builtin_bit_cast(float, w << 16); }
__device__ __forceinline__ float bfhi(unsigned w) { return __builtin_bit_cast(float, w & 0xffff0000u); }
__device__ __forceinline__ float sigmoidf_(float x) { return __builtin_amdgcn_rcpf(1.0f + __expf(-x)); }
__device__ __forceinline__ float wave_sum(float v) {
#pragma unroll
    for (int o = 1; o < 64; o <<= 1) v += __shfl_xor(v, o);
    return v;
}
template <int CTRL> __device__ __forceinline__ float dpp_f(float v) { return __builtin_bit_cast(float, __builtin_amdgcn_update_dpp(0, __builtin_bit_cast(int, v), CTRL, 0xf, 0xf, true)); }
__device__ __forceinline__ float sum8(float v) { v += dpp_f<0xB1>(v); v += dpp_f<0x4E>(v); v += dpp_f<0x141>(v); return v; }

struct Args { const float* in[24]; float* out; unsigned char* ws; };
__device__ __forceinline__ const float* karg_in(int i) {
    const unsigned char __attribute__((address_space(4)))* kp = (const unsigned char __attribute__((address_space(4)))*)__builtin_amdgcn_kernarg_segment_ptr();
    asm volatile("" : "+s"(kp));
    return *(const float* const __attribute__((address_space(4)))*)(kp + 8 * i);
}
__device__ __forceinline__ unsigned char* karg_ptr(int i) { return (unsigned char*)karg_in(i); }
#define KIN(i) karg_in(i)
#define KOUT() ((float*)karg_ptr(24))
#define KWS() (karg_ptr(25))
enum { I_X = 0, I_C, I_WMOD, I_BMOD, I_WIN, I_CONVW, I_MU, I_W0, I_WDU, I_A0, I_AUP, I_GUP, I_KK, I_KA, I_RK, I_LNXG, I_LNXB, I_WOUT, I_LN1G, I_LN1B, I_WFI, I_WFO, I_LN2G, I_LN2B };

__device__ __forceinline__ void transpose_item(const float* W, int K, int N, bf16* WT, int mode, float* scr, int item, int lane) {
    const int nblk = N / 32, kb = item / nblk, nb = item % nblk, k0 = 64 * kb, n0 = 32 * nb;
#pragma unroll 8
    for (int i = 0; i < 32; ++i) { const int kk = 2 * i + (lane >> 5); scr[kk * 33 + (lane & 31)] = W[(size_t)(k0 + kk) * N + n0 + (lane & 31)]; }
    asm volatile("s_waitcnt lgkmcnt(0)" ::: "memory");
    int d0 = n0;
    if (mode == 1) { const int bj = n0 / DFF, rem = n0 % DFF; d0 = 256 * (rem / 128) + 128 * bj + (rem % 128); }
    const int c = lane & 7;
#pragma unroll
    for (int j = 0; j < 4; ++j) { const int n = (lane >> 3) + 8 * j; const float* s = scr + (8 * c) * 33 + n;
        u32x4 o; o.x = pk2(s[0 * 33], s[1 * 33]); o.y = pk2(s[2 * 33], s[3 * 33]); o.z = pk2(s[4 * 33], s[5 * 33]); o.w = pk2(s[6 * 33], s[7 * 33]);
        *(u32x4*)(WT + (size_t)(d0 + n) * K + k0 + 8 * c) = o; }
    asm volatile("s_waitcnt lgkmcnt(0)" ::: "memory");
}

__device__ __forceinline__ void p0_weights(const Args& a, unsigned char* lds_g, int gw, int NGW, int wave, int lane) {
    float* scr = (float*)(lds_g + 32768 + wave * 8704);
    constexpr int I_IN = 16 * 104, I_OUT = 16 * 32, I_FI = 16 * 176, I_FO = 44 * 32, I_L = I_IN + I_OUT + I_FI + I_FO;
    for (int it = gw; it < DEPTH * I_L; it += NGW) {
        const int l = it / I_L; int r = it % I_L; unsigned char* wl = KWS() + WS_W + (size_t)l * W_LAYER;
        if (r < I_IN) { transpose_item(KIN(I_WIN) + (size_t)l * D * NIN, D, NIN, (bf16*)(wl + WO_IN), 0, scr, r, lane); continue; } r -= I_IN;
        if (r < I_OUT) { transpose_item(KIN(I_WOUT) + (size_t)l * D * D, D, D, (bf16*)(wl + WO_OUT), 0, scr, r, lane); continue; } r -= I_OUT;
        if (r < I_FI) { transpose_item(KIN(I_WFI) + (size_t)l * D * 2 * DFF, D, 2 * DFF, (bf16*)(wl + WO_FI), 1, scr, r, lane); continue; } r -= I_FI;
        transpose_item(KIN(I_WFO) + (size_t)l * DFF * D, DFF, D, (bf16*)(wl + WO_FO), 0, scr, r, lane);
    }
    const int gt = gw * 64 + lane, NGT = NGW * 64;
    for (int ch = gt; ch < DEPTH * NLN * 32; ch += NGT) {
        const int l = ch / (NLN * 32), rr = ch % (NLN * 32), n = rr / 32, k0 = 8 * (rr % 32), seg = n / 512, nn = n % 512;
        const float* src = nullptr;
        if (seg == 0 && k0 < 64) src = KIN(I_WDU) + (size_t)l * 64 * 512 + (size_t)k0 * 512 + nn;
        else if (seg == 1 && k0 >= 64 && k0 < 128) src = KIN(I_AUP) + (size_t)l * 64 * 512 + (size_t)(k0 - 64) * 512 + nn;
        else if (seg == 2 && k0 >= 128) src = KIN(I_GUP) + (size_t)l * 128 * 512 + (size_t)(k0 - 128) * 512 + nn;
        u32x4 o = (u32x4){0u, 0u, 0u, 0u};
        if (src) { o.x = pk2(src[0], src[512]); o.y = pk2(src[1024], src[1536]); o.z = pk2(src[2048], src[2560]); o.w = pk2(src[3072], src[3584]); }
        *(u32x4*)((bf16*)(KWS() + WS_W + (size_t)l * W_LAYER + WO_LORA) + (size_t)n * NLK + k0) = o;
    }
}
__device__ __forceinline__ void p0_mod(const Args& a, unsigned char* lds_g, int tid, int wave, int lane) {
    float* sc = (float*)lds_g;
    float* red = sc + 4096;
    const float* c = KIN(I_C);
    for (int i = tid; i < BATCH * D; i += NTHR) { const float v = c[i]; sc[i] = v / (1.0f + __expf(-v)); }
    __syncthreads();
    float* MOD = (float*)(KWS() + WS_MOD);
    for (int item = blockIdx.x; item < DEPTH * 96; item += gridDim.x) {
        const int l = item / 96, jc = item % 96;
        const float* wp = KIN(I_WMOD) + ((size_t)l * D + wave * 128) * NMOD + jc * 64 + lane;
        float a0 = 0.f, a1 = 0.f, a2 = 0.f, a3 = 0.f;
#pragma unroll 8
        for (int i = 0; i < 128; ++i) { const float w = wp[(size_t)i * NMOD]; const int ii = wave * 128 + i;
            a0 += sc[ii] * w; a1 += sc[1024 + ii] * w; a2 += sc[2048 + ii] * w; a3 += sc[3072 + ii] * w; }
        red[(wave * 4 + 0) * 64 + lane] = a0; red[(wave * 4 + 1) * 64 + lane] = a1; red[(wave * 4 + 2) * 64 + lane] = a2; red[(wave * 4 + 3) * 64 + lane] = a3;
        __syncthreads();
        if (tid < 256) { const int bb = tid >> 6, ln = tid & 63; float s = 0.f;
#pragma unroll
            for (int w = 0; w < 8; ++w) s += red[(w * 4 + bb) * 64 + ln];
            MOD[(size_t)(l * BATCH + bb) * NMOD + jc * 64 + ln] = s + KIN(I_BMOD)[(size_t)l * NMOD + jc * 64 + ln]; }
        __syncthreads();
    }
}
template <bool LN, bool WRITE_H, bool WRITE_X> __device__ __forceinline__ void row_pass(const float* xin, float* xout, float* stats, bf16* H, const float* lg, const float* lb, const float* modsh, const float* modsc, int gw, int NGW, int lane) {
    for (int m = gw; m < M; m += NGW) {
        const f32x4* xr = (const f32x4*)(xin + (size_t)m * D) + lane;
        f32x4 v[4];
#pragma unroll
        for (int j = 0; j < 4; ++j) v[j] = xr[64 * j];
        if (LN) {
            float s = 0.f;
#pragma unroll
            for (int j = 0; j < 4; ++j) s += (v[j].x + v[j].y) + (v[j].z + v[j].w);
            const float mean = wave_sum(s) * (1.f / D); float s2 = 0.f;
#pragma unroll
            for (int j = 0; j < 4; ++j) { v[j] = v[j] - mean; s2 += (v[j].x * v[j].x + v[j].y * v[j].y) + (v[j].z * v[j].z + v[j].w * v[j].w); }
            const float rstd = 1.f / sqrtf(wave_sum(s2) * (1.f / D) + LN_EPS);
            f32x4* xo = (f32x4*)(xout + (size_t)m * D) + lane;
            if (!WRITE_X && lane == 0) { stats[2 * (size_t)m] = mean; stats[2 * (size_t)m + 1] = rstd; }
#pragma unroll
            for (int j = 0; j < 4; ++j) { const f32x4 g = ((const f32x4*)lg)[lane + 64 * j], bb = ((const f32x4*)lb)[lane + 64 * j]; v[j] = v[j] * rstd * g + bb; if (WRITE_X) xo[64 * j] = v[j]; }
        }
        if (WRITE_H) {
            const int b = m / SEQ;
            const f32x4* sh = (const f32x4*)(modsh + (size_t)b * NMOD) + lane; const f32x4* sc = (const f32x4*)(modsc + (size_t)b * NMOD) + lane;
            u32x2* ho = (u32x2*)(H + (size_t)m * D) + lane;
#pragma unroll
            for (int j = 0; j < 4; ++j) { const f32x4 h = v[j] * (sc[64 * j] + 1.0f) + sh[64 * j]; u32x2 o; o.x = pk2(h.x, h.y); o.y = pk2(h.z, h.w); ho[64 * j] = o; }
        }
    }
}
__device__ __forceinline__ void p2a_conv_act(const bf16* P, bf16* MIX, bf16* ACT, const float* convw, const float* mu, int gw, int NGW, int lane) {
    float cw[3][8];
#pragma unroll
    for (int k = 0; k < 3; ++k)
#pragma unroll
        for (int i = 0; i < 8; ++i) cw[k][i] = convw[k * 512 + lane * 8 + i];
    float mul[4];
#pragma unroll
    for (int i = 0; i < 4; ++i) mul[i] = mu[1536 + lane * 4 + i];
    for (int run = gw; run < M / 16; run += NGW) {
        const int m0 = run * 16, t0 = m0 % SEQ;
        float z1[8], z2[8], pl[4];
#pragma unroll
        for (int i = 0; i < 8; ++i) { z1[i] = 0.f; z2[i] = 0.f; }
#pragma unroll
        for (int i = 0; i < 4; ++i) pl[i] = 0.f;
        if (t0 > 0) {
            const bf16* p1 = P + (size_t)(m0 - 1) * NIN; const bf16* p2 = P + (size_t)(m0 - 2) * NIN;
            const u32x4 c1 = *(const u32x4*)(p1 + 512 + lane * 8), u1 = *(const u32x4*)(p1 + 1024 + lane * 8);
            const u32x4 c2 = *(const u32x4*)(p2 + 512 + lane * 8), u2 = *(const u32x4*)(p2 + 1024 + lane * 8);
#pragma unroll
            for (int q = 0; q < 4; ++q) { z1[2 * q] = bflo(c1[q]) * bflo(u1[q]); z1[2 * q + 1] = bfhi(c1[q]) * bfhi(u1[q]); z2[2 * q] = bflo(c2[q]) * bflo(u2[q]); z2[2 * q + 1] = bfhi(c2[q]) * bfhi(u2[q]); }
            const u32x2 l1 = *(const u32x2*)(p1 + 3072 + lane * 4);
            pl[0] = bflo(l1.x); pl[1] = bfhi(l1.x); pl[2] = bflo(l1.y); pl[3] = bfhi(l1.y);
        }
        for (int tt = 0; tt < 16; ++tt) {
            const bf16* p0 = P + (size_t)(m0 + tt) * NIN;
            const u32x4 bb = *(const u32x4*)(p0 + lane * 8), cc = *(const u32x4*)(p0 + 512 + lane * 8), uu = *(const u32x4*)(p0 + 1024 + lane * 8);
            const u32x2 ll = *(const u32x2*)(p0 + 3072 + lane * 4);
            float z0[8], bg[8], y[8];
#pragma unroll
            for (int q = 0; q < 4; ++q) { z0[2 * q] = bflo(cc[q]) * bflo(uu[q]); z0[2 * q + 1] = bfhi(cc[q]) * bfhi(uu[q]); bg[2 * q] = bflo(bb[q]); bg[2 * q + 1] = bfhi(bb[q]); }
#pragma unroll
            for (int i = 0; i < 8; ++i) { y[i] = bg[i] * (cw[0][i] * z2[i] + cw[1][i] * z1[i] + cw[2][i] * z0[i]); z2[i] = z1[i]; z1[i] = z0[i]; }
            u32x4 o; o.x = pk2(y[0], y[1]); o.y = pk2(y[2], y[3]); o.z = pk2(y[4], y[5]); o.w = pk2(y[6], y[7]);
            *(u32x4*)(MIX + (size_t)(m0 + tt) * D + lane * 8) = o;
            float cur[4] = {bflo(ll.x), bfhi(ll.x), bflo(ll.y), bfhi(ll.y)}, av[4];
#pragma unroll
            for (int i = 0; i < 4; ++i) { const float xs = cur[i] + mul[i] * (pl[i] - cur[i]); pl[i] = cur[i];
                av[i] = (lane < 16) ? tanhf(xs) : ((lane < 32) ? xs : sigmoidf_(xs)); }
            u32x2 oa; oa.x = pk2(av[0], av[1]); oa.y = pk2(av[2], av[3]);
            *(u32x2*)(ACT + (size_t)(m0 + tt) * NLK + lane * 4) = oa;
        }
    }
}
template <int CTRL, int RMASK> __device__ __forceinline__ float dpp_m(float v) { return __builtin_bit_cast(float, __builtin_amdgcn_update_dpp(0, __builtin_bit_cast(int, v), CTRL, RMASK, 0xf, true)); }
__device__ __forceinline__ float wave_total(float v) {
    v += dpp_m<0x111, 0xf>(v); v += dpp_m<0x112, 0xf>(v); v += dpp_m<0x114, 0xf>(v); v += dpp_m<0x118, 0xf>(v);
    v += dpp_m<0x142, 0xa>(v);
    v += dpp_m<0x143, 0xc>(v);
    return __builtin_bit_cast(float, __builtin_amdgcn_readlane(__builtin_bit_cast(int, v), 63));
}
typedef short s4v __attribute__((ext_vector_type(4)));
typedef float f32x2_t __attribute__((ext_vector_type(2)));
typedef __bf16 bf16x2_t __attribute__((ext_vector_type(2)));
typedef LAS unsigned short LB;
__device__ __forceinline__ unsigned cvtpk(float lo, float hi) { f32x2_t v = {lo, hi}; bf16x2_t b = __builtin_convertvector(v, bf16x2_t); return __builtin_bit_cast(unsigned, b); }
constexpr int LDT = 24, LDJ = 72;
constexpr int SZ_J = 16 * LDJ * 2, SZ_C = 64 * LDT * 2, SZ_S = 16 * LDT * 2;
constexpr int SL_AT = 0, SL_QE = SL_AT + SZ_J, SL_BPT = SL_QE + SZ_J, SL_KET = SL_BPT + SZ_C, SL_VT = SL_KET + SZ_C, SL_WV = SL_VT + SZ_C, SL_PC = SL_WV + SZ_S, SL_BON = SL_PC + 256, SLOT_BYTES = SL_BON + 64;
constexpr int SC_BT = 0, SC_KT = SC_BT + SZ_J, SC_RT = SC_KT + SZ_J, SC_ATT = SC_RT + SZ_J, SC_BTT = SC_ATT + SZ_C, SC_NP = SC_BTT + SZ_C, SC_NPT = SC_NP + SZ_S, SC_TM = SC_NPT + SZ_S, SC_TT = SC_TM + SZ_S,
              SC_NAKT = SC_TT + SZ_S, SC_MRB = SC_NAKT + SZ_S, SC_X = SC_MRB + SZ_S, SCR_BYTES = SC_X + SZ_S;
constexpr int CK_SLOTS = 0, CK_SCR = 4 * SLOT_BYTES, CK_YBUF = CK_SCR + 4 * SCR_BYTES, CK_END = CK_YBUF + 64 * 64 * 2;
static_assert(SLOT_BYTES % 16 == 0 && SCR_BYTES % 16 == 0 && CK_END <= LDS_BYTES, "chunked-scan LDS map");
__device__ __forceinline__ f32x4 mm16(const LB* A, int lda, const LB* BT, int ldb, f32x4 acc, int c, int q) {
    const s4v a = *(const LAS s4v*)(A + c * lda + 4 * q);
    const s4v b = *(const LAS s4v*)(BT + c * ldb + 4 * q);
    return __builtin_amdgcn_mfma_f32_16x16x16bf16_1k(a, b, acc, 0, 0, 0);
}
__device__ __forceinline__ f32x4 mm64(const LB* A, const LB* BT, int c, int q) {
    f32x4 acc = {0.f, 0.f, 0.f, 0.f};
#pragma unroll
    for (int ks = 0; ks < 4; ++ks) acc = mm16(A + 16 * ks, LDJ, BT + 16 * ks, LDJ, acc, c, q);
    return acc;
}
__device__ __forceinline__ void stT(LB* O, int ldo, f32x4 v, int c, int q) { u32x2 w; w.x = cvtpk(v[0], v[1]); w.y = cvtpk(v[2], v[3]); *(LAS u32x2*)(O + c * ldo + 4 * q) = w; }
__device__ __forceinline__ void stN(LB* O, int ldo, f32x4 v, int c, int q) {
#pragma unroll
    for (int r = 0; r < 4; r += 2) { const unsigned w = cvtpk(v[r], v[r + 1]); O[(4 * q + r) * ldo + c] = (unsigned short)w; O[(4 * q + r + 1) * ldo + c] = (unsigned short)(w >> 16); }
}
__device__ __forceinline__ s4v bf4(f32x4 v) { u32x2 w; w.x = cvtpk(v[0], v[1]); w.y = cvtpk(v[2], v[3]); return __builtin_bit_cast(s4v, w); }

constexpr int NSEG = 8, SEG_SS = SEQ / 64 / NSEG;
template <int PASS> __device__ __forceinline__ void p3_chunked(int l, unsigned char* lds_g, const bf16* P, const bf16* LORA, bf16* MIX, float* SEG, int tid, int wave, int lane) {
    if (blockIdx.x >= BATCH * NH * NSEG) return;
    const int bh = blockIdx.x & 31, seg = blockIdx.x >> 5, b = bh >> 3, h = bh & 7;
    LAS unsigned char* lds = (LAS unsigned char*)lds_g;
    const int c = lane & 15, q = lane >> 4;
    const int hc = h * 64 + lane;
    const float* mu = KIN(I_MU) + (size_t)l * 1792;
    const float mu_r = mu[hc], mu_k = mu[512 + hc], mu_v = mu[1024 + hc];
    const float w0c = KIN(I_W0)[l * 512 + hc], a0c = KIN(I_A0)[l * 512 + hc], kkc = KIN(I_KK)[l * 512 + hc], kac = KIN(I_KA)[l * 512 + hc], rkc = KIN(I_RK)[l * 512 + hc];
    const float lgc = KIN(I_LNXG)[l * 512 + hc], lbc = KIN(I_LNXB)[l * 512 + hc];
    f32x4 Sreg[4], Greg[4];
#pragma unroll
    for (int T = 0; T < 4; ++T) { Sreg[T] = (f32x4){0.f, 0.f, 0.f, 0.f};
#pragma unroll
        for (int r = 0; r < 4; ++r) Greg[T][r] = (PASS == 1 && 16 * T + 4 * q + r == 16 * (wave & 3) + c) ? 1.0f : 0.0f; }
    if (PASS == 2 && wave < 4) {
        for (int s = 0; s < seg; ++s) {
            const float* Gt = SEG + ((size_t)(bh * NSEG + s) * 2 + 0) * 4096; const float* Ht = SEG + ((size_t)(bh * NSEG + s) * 2 + 1) * 4096;
            s4v sb[4];
#pragma unroll
            for (int T = 0; T < 4; ++T) sb[T] = bf4(Sreg[T]);
#pragma unroll
            for (int T2 = 0; T2 < 4; ++T2) {
                f32x4 acc;
#pragma unroll
                for (int r = 0; r < 4; ++r) acc[r] = Ht[(16 * T2 + 4 * q + r) * 64 + 16 * wave + c];
#pragma unroll
                for (int T = 0; T < 4; ++T) { const f32x4 gv = *(const f32x4*)(Gt + (16 * T2 + c) * 64 + 16 * T + 4 * q);
                    acc = __builtin_amdgcn_mfma_f32_16x16x16bf16_1k(bf4(gv), sb[T], acc, 0, 0, 0); }
                Sreg[T2] = acc;
            }
        }
    }
    const bf16* Pb = P + (size_t)b * SEQ * NIN + SHIFT0 + hc;
    const bf16* Lb = LORA + (size_t)b * SEQ * NLN + hc;
    const int pw = wave & 3, half = wave >> 2;
    unsigned short raw[8][5], rawp[3], rawlw[8], graw[8];
#define LOAD_RAW(ssn) do { const int tok0_ = 16 * (4 * (ssn) + pw) + 8 * half; \
        if (tok0_ > 0) { const bf16* pp_ = Pb + (size_t)(tok0_ - 1) * NIN; rawp[0] = pp_[0]; rawp[1] = pp_[512]; rawp[2] = pp_[1024]; } else { rawp[0] = 0; rawp[1] = 0; rawp[2] = 0; } \
        _Pragma("unroll") for (int t_ = 0; t_ < 8; ++t_) { const bf16* pc_ = Pb + (size_t)(tok0_ + t_) * NIN; const bf16* lc_ = Lb + (size_t)(tok0_ + t_) * NLN; \
            raw[t_][0] = pc_[0]; raw[t_][1] = pc_[512]; raw[t_][2] = pc_[1024]; raw[t_][3] = lc_[0]; raw[t_][4] = lc_[512]; \
            rawlw[t_] = half ? Lb[(size_t)(tok0_ - 8 + t_) * NLN] : (unsigned short)0; \
            if (PASS == 2) graw[t_] = Lb[((size_t)(ssn) * 64 + wave * 8 + t_) * NLN + 1024]; } } while (0)
    LOAD_RAW(seg * SEG_SS);
    for (int ss = seg * SEG_SS; ss < (seg + 1) * SEG_SS; ++ss) {
        unsigned short gcur[8];
#pragma unroll
        for (int i_ = 0; i_ < 8; ++i_) gcur[i_] = graw[i_];
        {
            LB* SL = (LB*)(lds + CK_SLOTS + pw * SLOT_BYTES); LB* SC = (LB*)(lds + CK_SCR + pw * SCR_BYTES);
            LB* sAt = SL + SL_AT / 2; LB* sVT = SL + SL_VT / 2; LAS float* sPC = (LAS float*)(SL + SL_PC / 2); LAS float* sBon = (LAS float*)(SL + SL_BON / 2);
            LB* cBt = SC + SC_BT / 2; LB* cKt = SC + SC_KT / 2; LB* cRt = SC + SC_RT / 2; LB* cATT = SC + SC_ATT / 2; LB* cBTT = SC + SC_BTT / 2;
            float pr = bf2f(rawp[0]), pk = bf2f(rawp[1]), pv = bf2f(rawp[2]), cs = 0.f;
            if (half) {
#pragma unroll
                for (int t = 0; t < 8; ++t) cs += 0.6065306597126334f * sigmoidf_(w0c + bf2f(rawlw[t]));
            }
            float ptp = __expf(-cs);
            unsigned pkA[4], pkB[4], pkV[4]; float loA = 0.f, loB = 0.f, loV = 0.f;
#pragma unroll
            for (int t8 = 0; t8 < 8; ++t8) {
                const int t = 8 * half + t8;
                const float cr = bf2f(raw[t8][0]), ck = bf2f(raw[t8][1]), cv = bf2f(raw[t8][2]), lw = bf2f(raw[t8][3]), la = bf2f(raw[t8][4]);
                const float r = cr + mu_r * (pr - cr), k = ck + mu_k * (pk - ck), v = cv + mu_v * (pv - cv);
                pr = cr; pk = ck; pv = cv;
                const float e = 0.6065306597126334f * sigmoidf_(w0c + lw);
                const float lr = sigmoidf_(a0c + la);
                const float kkv = k * kkc; const float n2 = wave_total(kkv * kkv);
                const float kk = kkv * __builtin_amdgcn_rsqf(fmaxf(n2, 1e-24f));
                const float k2 = k * (1.0f + (lr - 1.0f) * kac);
                const float bon = wave_total(r * k2 * rkc);
                const float pm1 = ptp; cs += e; const float pt = __expf(-cs), ipt = __builtin_amdgcn_rcpf(pt); ptp = pt;
                const float At_ = -kk * pm1, Bt_ = kk * lr * ipt, Kt_ = k2 * ipt, Rt_ = r * pt;
                { const unsigned ab = cvtpk(At_, Bt_), kr = cvtpk(Kt_, Rt_); sAt[t * LDJ + lane] = (unsigned short)ab; cBt[t * LDJ + lane] = (unsigned short)(ab >> 16); cKt[t * LDJ + lane] = (unsigned short)kr; cRt[t * LDJ + lane] = (unsigned short)(kr >> 16); }
                if (lane == 0) sBon[t] = bon;
                if (t8 & 1) { pkA[t8 >> 1] = cvtpk(loA, At_); pkB[t8 >> 1] = cvtpk(loB, Bt_); pkV[t8 >> 1] = cvtpk(loV, v); } else { loA = At_; loB = Bt_; loV = v; }
            }
            if (half) sPC[lane] = ptp;
            *(LAS u32x4*)(cATT + lane * LDT + 8 * half) = (u32x4){pkA[0], pkA[1], pkA[2], pkA[3]};
            *(LAS u32x4*)(cBTT + lane * LDT + 8 * half) = (u32x4){pkB[0], pkB[1], pkB[2], pkB[3]};
            *(LAS u32x4*)(sVT + lane * LDT + 8 * half) = (u32x4){pkV[0], pkV[1], pkV[2], pkV[3]};
            if (ss + 1 < (seg + 1) * SEG_SS) LOAD_RAW(ss + 1);
        }
        __syncthreads();
        if (wave < 4) {
            LB* SL = (LB*)(lds + CK_SLOTS + wave * SLOT_BYTES); LB* SC = (LB*)(lds + CK_SCR + wave * SCR_BYTES);
            LB* sAt = SL + SL_AT / 2; LB* sQe = SL + SL_QE / 2; LB* sBpT = SL + SL_BPT / 2; LB* sKeT = SL + SL_KET / 2; LB* sWv = SL + SL_WV / 2;
            LB* cBt = SC + SC_BT / 2; LB* cKt = SC + SC_KT / 2; LB* cRt = SC + SC_RT / 2; LB* cATT = SC + SC_ATT / 2; LB* cBTT = SC + SC_BTT / 2;
            LB* cNp = SC + SC_NP / 2; LB* cNpT = SC + SC_NPT / 2; LB* cTm = SC + SC_TM / 2; LB* cTT = SC + SC_TT / 2; LB* cNakT = SC + SC_NAKT / 2; LB* cMrb = SC + SC_MRB / 2; LB* cX = SC + SC_X / 2;
            f32x4 Nab = mm64(sAt, cBt, c, q), Nak = mm64(sAt, cKt, c, q), Mrb = mm64(cRt, cBt, c, q), Mrk = mm64(cRt, cKt, c, q);
#pragma unroll
            for (int r = 0; r < 4; ++r) { const int t = 4 * q + r; if (!(t > c)) { Nab[r] = 0.f; Nak[r] = 0.f; } if (!(t >= c)) { Mrb[r] = 0.f; Mrk[r] = 0.f; } }
            stN(cNp, LDT, Nab, c, q); stT(cNpT, LDT, Nab, c, q); stT(cNakT, LDT, Nak, c, q); stN(cMrb, LDT, Mrb, c, q);
            f32x4 Tr = Nab;
#pragma unroll
            for (int r = 0; r < 4; ++r) if (4 * q + r == c) Tr[r] += 1.0f;
#pragma unroll
            for (int it = 0; it < 3; ++it) {
                stN(cTm, LDT, Tr, c, q);
                const f32x4 N2 = mm16(cNp, LDT, cNpT, LDT, (f32x4){0.f, 0.f, 0.f, 0.f}, c, q);
                stN(cNp, LDT, N2, c, q); stT(cNpT, LDT, N2, c, q);
                Tr = mm16(cTm, LDT, cNpT, LDT, Tr, c, q);
            }
            stT(cTT, LDT, Tr, c, q);
            const f32x4 Xr = mm16(cMrb, LDT, cTT, LDT, (f32x4){0.f, 0.f, 0.f, 0.f}, c, q);
            stN(cX, LDT, Xr, c, q);
            if (PASS == 2) { const f32x4 Wv = mm16(cX, LDT, cNakT, LDT, Mrk, c, q); stN(sWv, LDT, Wv, c, q); }
#pragma unroll
            for (int jt = 0; jt < 4; ++jt) {
                f32x4 a0;
#pragma unroll
                for (int r = 0; r < 4; ++r) a0[r] = bf2f(cRt[(4 * q + r) * LDJ + 16 * jt + c]);
                if (PASS == 2) { const f32x4 Qe = mm16(cX, LDT, cATT + 16 * jt * LDT, LDT, a0, c, q);
                    stN(sQe + 16 * jt, LDJ, Qe, c, q); }
                const f32x4 Bp = mm16(cTT, LDT, cBTT + 16 * jt * LDT, LDT, (f32x4){0.f, 0.f, 0.f, 0.f}, c, q);
                stT(sBpT + 16 * jt * LDT, LDT, Bp, c, q);
                f32x4 k0;
#pragma unroll
                for (int r = 0; r < 4; ++r) k0[r] = bf2f(cKt[(4 * q + r) * LDJ + 16 * jt + c]);
                const f32x4 Ke = mm16(cNakT, LDT, sBpT + 16 * jt * LDT, LDT, k0, c, q);
                stT(sKeT + 16 * jt * LDT, LDT, Ke, c, q);
            }
        }
        __syncthreads();
        if (wave < 4) {
            LB* ybuf = (LB*)(lds + CK_YBUF);
#pragma unroll 1
            for (int cl = 0; cl < 4; ++cl) {
                LB* SL = (LB*)(lds + CK_SLOTS + cl * SLOT_BYTES);
                LB* sAt = SL + SL_AT / 2; LB* sQe = SL + SL_QE / 2; LB* sBpT = SL + SL_BPT / 2; LB* sKeT = SL + SL_KET / 2; LB* sVT = SL + SL_VT / 2; LB* sWv = SL + SL_WV / 2;
                LAS float* sPC = (LAS float*)(SL + SL_PC / 2);
                s4v sb[4], gb[4];
#pragma unroll
                for (int T = 0; T < 4; ++T) { sb[T] = bf4(Sreg[T]); gb[T] = bf4(Greg[T]); }
                const s4v vb = *(const LAS s4v*)(sVT + (16 * wave + c) * LDT + 4 * q);
                f32x4 X = {0.f, 0.f, 0.f, 0.f}, Y = {0.f, 0.f, 0.f, 0.f}, XG = {0.f, 0.f, 0.f, 0.f};
#pragma unroll
                for (int T = 0; T < 4; ++T) {
                    const s4v at = *(const LAS s4v*)(sAt + c * LDJ + 16 * T + 4 * q);
                    X = __builtin_amdgcn_mfma_f32_16x16x16bf16_1k(at, sb[T], X, 0, 0, 0);
                    if (PASS == 1) XG = __builtin_amdgcn_mfma_f32_16x16x16bf16_1k(at, gb[T], XG, 0, 0, 0);
                    if (PASS == 2) Y = __builtin_amdgcn_mfma_f32_16x16x16bf16_1k(*(const LAS s4v*)(sQe + c * LDJ + 16 * T + 4 * q), sb[T], Y, 0, 0, 0);
                }
                if (PASS == 2) Y = __builtin_amdgcn_mfma_f32_16x16x16bf16_1k(*(const LAS s4v*)(sWv + c * LDT + 4 * q), vb, Y, 0, 0, 0);
                const s4v xb = bf4(X), xgb = bf4(XG);
#pragma unroll
                for (int T = 0; T < 4; ++T) {
                    f32x4 s = Sreg[T];
                    const s4v bp = *(const LAS s4v*)(sBpT + (16 * T + c) * LDT + 4 * q);
                    s = __builtin_amdgcn_mfma_f32_16x16x16bf16_1k(bp, xb, s, 0, 0, 0);
                    s = __builtin_amdgcn_mfma_f32_16x16x16bf16_1k(*(const LAS s4v*)(sKeT + (16 * T + c) * LDT + 4 * q), vb, s, 0, 0, 0);
                    const f32x4 pc = *(const LAS f32x4*)(sPC + 16 * T + 4 * q);
                    Sreg[T] = s * pc;
                    if (PASS == 1) Greg[T] = __builtin_amdgcn_mfma_f32_16x16x16bf16_1k(bp, xgb, Greg[T], 0, 0, 0) * pc;
                }
                if (PASS == 2) {
#pragma unroll
                    for (int r = 0; r < 4; r += 2) { const unsigned w = cvtpk(Y[r], Y[r + 1]); ybuf[(cl * 16 + 4 * q + r) * 64 + 16 * wave + c] = (unsigned short)w; ybuf[(cl * 16 + 4 * q + r + 1) * 64 + 16 * wave + c] = (unsigned short)(w >> 16); }
                }
            }
        }
        __syncthreads();
        if (PASS == 2) {
            const LB* ybuf = (const LB*)(lds + CK_YBUF);
#pragma unroll
            for (int i = 0; i < 8; ++i) {
                const int tt = wave * 8 + i, cl = tt >> 4, t = tt & 15; const size_t tok = (size_t)ss * 64 + tt;
                const LB* SL = (const LB*)(lds + CK_SLOTS + cl * SLOT_BYTES);
                const float g = bf2f(gcur[i]);
                const float y = bf2f(ybuf[tt * 64 + lane]), v = bf2f(SL[SL_VT / 2 + lane * LDT + t]), bon = ((const LAS float*)(SL + SL_BON / 2))[t];
                const float mean = wave_total(y) * (1.f / 64.f); const float d = y - mean; const float var = wave_total(d * d) * (1.f / 64.f);
                const float yn = d * __builtin_amdgcn_rsqf(var + GN_EPS) * lgc + lbc;
                MIX[((size_t)b * SEQ + tok) * D + 512 + hc] = (bf16)f2bf((yn + bon * v) * g);
            }
        }
        if (PASS == 2) __syncthreads();
    }
    if (PASS == 1 && wave < 4) {
        float* Gt = SEG + ((size_t)(bh * NSEG + seg) * 2 + 0) * 4096; float* Ht = SEG + ((size_t)(bh * NSEG + seg) * 2 + 1) * 4096;
#pragma unroll
        for (int T = 0; T < 4; ++T)
#pragma unroll
            for (int r = 0; r < 4; ++r) { Gt[(16 * T + 4 * q + r) * 64 + 16 * wave + c] = Greg[T][r]; Ht[(16 * T + 4 * q + r) * 64 + 16 * wave + c] = Sreg[T][r]; }
    }
#undef LOAD_RAW
}

#define XB_TMO      128
#define XB_XCNT(j)  (256  + 64 * (j))
#define XB_XSUB(j)  (1280 + 64 * (j))
#define XB_XGEN(j)  (2304 + 64 * (j))
#define XB_TOP      3328
#define XB_TOPGEN   3392
#define XCD_BAR_WORDS 3456
#define XB_SPIN_CAP (1u << 18)

__device__ __forceinline__ unsigned xb_ld(unsigned* p)              { return __hip_atomic_load(p, __ATOMIC_RELAXED, __HIP_MEMORY_SCOPE_AGENT); }
__device__ __forceinline__ unsigned xb_add(unsigned* p, unsigned v) { return __hip_atomic_fetch_add(p, v, __ATOMIC_RELAXED, __HIP_MEMORY_SCOPE_AGENT); }
__device__ __forceinline__ unsigned xb_xcc_id() { return (unsigned)__builtin_amdgcn_s_getreg((3 << 11) | 20) & 0xFu; }
#define XB_SPIN(cond, bar) do { unsigned _sp = 0; while (cond) { __builtin_amdgcn_s_sleep(1); \
    if ((++_sp & 255u) == 0u) { if (xb_ld(&(bar)[XB_TMO])) break; if (_sp > XB_SPIN_CAP) { atomicAdd(&(bar)[XB_TMO], 1u); break; } } } } while (0)

struct XcdBarrier {
    unsigned* bar; unsigned x;
    volatile LAS unsigned* st;
};

__device__ __forceinline__ XcdBarrier xcd_barrier_post(unsigned* bar, volatile LAS unsigned* st) {
    XcdBarrier b; b.bar = bar; b.x = xb_xcc_id(); b.st = st;
    if (threadIdx.x == 0) (void)xb_add(&bar[XB_XCNT(b.x)], 1u);
    return b;
}
__device__ __forceinline__ void xcd_barrier_complete(unsigned* bar, unsigned x, unsigned& nloc, unsigned& nx) {
    const unsigned G = gridDim.x * gridDim.y * gridDim.z;
    unsigned sum, cnt, mine, sp = 0u;
    for (;;) {
        sum = 0u; cnt = 0u; mine = 0u;
#pragma unroll
        for (unsigned j = 0; j < 16; ++j) { const unsigned c = xb_ld(&bar[XB_XCNT(j)]); sum += c; cnt += (c > 0u) ? 1u : 0u; mine = (j == x) ? c : mine; }
        if (sum == G) break;
        __builtin_amdgcn_s_sleep(1);
        if ((++sp & 255u) == 0u) { if (xb_ld(&bar[XB_TMO])) break; if (sp > XB_SPIN_CAP) { atomicAdd(&bar[XB_TMO], 1u); break; } }
    }
    nloc = mine > 0u ? mine : 1u; nx = cnt > 0u ? cnt : 1u;
}

__device__ __forceinline__ void xcd_barrier(const XcdBarrier& b) {
    asm volatile("s_waitcnt vmcnt(0)" ::: "memory");
    __syncthreads();
    if (threadIdx.x == 0) {
        unsigned* bar = b.bar;
        __builtin_amdgcn_s_waitcnt(0);
        unsigned nloc = b.st[0], nx = b.st[1];
        if (nloc == 0u) { xcd_barrier_complete(bar, b.x, nloc, nx); b.st[0] = nloc; b.st[1] = nx; }
        const unsigned old = xb_add(&bar[XB_XSUB(b.x)], 1u);
        const unsigned gen = old / nloc;
        if (old + 1u == (gen + 1u) * nloc) {
            __builtin_amdgcn_fence(__ATOMIC_RELEASE, "agent");
            asm volatile("s_waitcnt vmcnt(0)" ::: "memory");
            const unsigned og = xb_add(&bar[XB_TOP], 1u);
            const unsigned tg = og / nx;
            if (og + 1u == (tg + 1u) * nx) xb_add(&bar[XB_TOPGEN], 1u);
            else XB_SPIN(xb_ld(&bar[XB_TOPGEN]) == tg, bar);
            __builtin_amdgcn_fence(__ATOMIC_ACQUIRE, "agent");
            xb_add(&bar[XB_XGEN(b.x)], 1u);
            asm volatile("s_waitcnt vmcnt(0)" ::: "memory");
        } else {
            XB_SPIN(xb_ld(&bar[XB_XGEN(b.x)]) == gen, bar);
            __builtin_amdgcn_fence(__ATOMIC_ACQUIRE, "agent");
            asm volatile("s_waitcnt vmcnt(0)" ::: "memory");
        }
    }
    __syncthreads();
}

constexpr int XB_ST_OFF = LDS_BYTES - 64;
static_assert(CK_END <= XB_ST_OFF && pg8::STAGE_BYTES <= XB_ST_OFF, "barrier LDS words clear of the phase scratch");
__global__ void __launch_bounds__(NTHR, 2) fwd_megakernel(Args a) {
    extern __shared__ __attribute__((aligned(16))) unsigned char lds_g[];
    cg::grid_group grid = cg::this_grid();
#define PHASE_IDS() int tid = threadIdx.x; asm volatile("" : "+v"(tid)); const int lane = tid & 63, wave = __builtin_amdgcn_readfirstlane(tid >> 6); const int G = gridDim.x, gw = blockIdx.x * NWAVES + wave, NGW = G * NWAVES; (void)lane; (void)gw; (void)NGW; (void)G
#define WSP(T, off) ((T*)(KWS() + (off)))
#define LDS_P ((PG8_LAS unsigned char*)lds_g)
    if (threadIdx.x == 0) { ((volatile LAS unsigned*)((LAS unsigned char*)lds_g + XB_ST_OFF))[0] = 0u; ((volatile LAS unsigned*)((LAS unsigned char*)lds_g + XB_ST_OFF))[1] = 0u; }
    __syncthreads();
    (void)xcd_barrier_post((unsigned*)KWS(), (volatile LAS unsigned*)((LAS unsigned char*)lds_g + XB_ST_OFF));
#define GSYNC() do { XcdBarrier b_; b_.bar = (unsigned*)KWS(); b_.x = xb_xcc_id(); b_.st = (volatile LAS unsigned*)((LAS unsigned char*)lds_g + XB_ST_OFF); xcd_barrier(b_); } while (0)
    { PHASE_IDS(); p0_mod(a, lds_g, tid, wave, lane); p0_weights(a, lds_g, gw, NGW, wave, lane); }
    grid.sync();
    { PHASE_IDS(); const float* MOD = WSP(const float, WS_MOD); row_pass<false, true, false>(KIN(I_X), nullptr, nullptr, WSP(bf16, WS_H), nullptr, nullptr, MOD + 0, MOD + 1024, gw, NGW, lane); }
    GSYNC();

    for (int l = 0; l < DEPTH; ++l) {
        { pg8::Gemm g{WSP(const bf16, WS_H), WSP(const bf16, WS_W + (size_t)l * W_LAYER + WO_IN), M, NIN, D}; pg8::StaticOrder S; S.init(M, NIN, (int)gridDim.x, (int)blockIdx.x); pg8::EpiBf16 E{WSP(bf16, WS_P), NIN};
          pg8::gemm_phase<pg8::EpiBf16, pg8::StaticOrder, true, true>(LDS_P, g, S, E); }
        GSYNC();
        { PHASE_IDS(); p2a_conv_act(WSP(const bf16, WS_P), WSP(bf16, WS_MIX), WSP(bf16, WS_ACT), KIN(I_CONVW) + (size_t)l * 3 * 512, KIN(I_MU) + (size_t)l * 1792, gw, NGW, lane); }
        GSYNC();
        { pg8::Gemm g{WSP(const bf16, WS_ACT), WSP(const bf16, WS_W + (size_t)l * W_LAYER + WO_LORA), M, NLN, NLK}; pg8::StaticOrder S; S.init(M, NLN, (int)gridDim.x, (int)blockIdx.x); pg8::EpiBf16 E{WSP(bf16, WS_LORA), NLN};
          pg8::gemm_phase<pg8::EpiBf16, pg8::StaticOrder, true, true>(LDS_P, g, S, E); }
        GSYNC();
        { PHASE_IDS(); p3_chunked<1>(l, lds_g, WSP(const bf16, WS_P), WSP(const bf16, WS_LORA), WSP(bf16, WS_MIX), WSP(float, WS_ACT), tid, wave, lane); }
        GSYNC();
        { PHASE_IDS(); p3_chunked<2>(l, lds_g, WSP(const bf16, WS_P), WSP(const bf16, WS_LORA), WSP(bf16, WS_MIX), WSP(float, WS_ACT), tid, wave, lane); }
        GSYNC();
        { pg8::Gemm g{WSP(const bf16, WS_MIX), WSP(const bf16, WS_W + (size_t)l * W_LAYER + WO_OUT), M, D, D}; pg8::StaticOrder S; S.init(M, D, (int)gridDim.x, (int)blockIdx.x);
          pg8::EpiRes E{l == 0 ? KIN(I_X) : (const float*)KOUT(), KOUT(), WSP(const float, WS_MOD) + (size_t)l * BATCH * NMOD + 2048, ALPHA,
                        l == 0 ? (const float*)nullptr : WSP(const float, WS_STATS), KIN(I_LN2G) + (size_t)(l > 0 ? l - 1 : 0) * D, KIN(I_LN2B) + (size_t)(l > 0 ? l - 1 : 0) * D};
          pg8::gemm_phase<pg8::EpiRes, pg8::StaticOrder, true, true>(LDS_P, g, S, E); }
        GSYNC();
        { PHASE_IDS(); const float* modl = WSP(const float, WS_MOD) + (size_t)l * BATCH * NMOD;
          row_pass<true, true, false>(KOUT(), KOUT(), WSP(float, WS_STATS), WSP(bf16, WS_H), KIN(I_LN1G) + (size_t)l * D, KIN(I_LN1B) + (size_t)l * D, modl + 3072, modl + 4096, gw, NGW, lane); }
        GSYNC();
        { pg8::Gemm g{WSP(const bf16, WS_H), WSP(const bf16, WS_W + (size_t)l * W_LAYER + WO_FI), M, 2 * DFF, D}; pg8::StaticOrder S; S.init(M, 2 * DFF, (int)gridDim.x, (int)blockIdx.x); pg8::EpiSwiGLU E{WSP(bf16, WS_P), DFF};
          pg8::gemm_phase<pg8::EpiSwiGLU, pg8::StaticOrder, true, true>(LDS_P, g, S, E); }
        GSYNC();
        { pg8::Gemm g{WSP(const bf16, WS_P), WSP(const bf16, WS_W + (size_t)l * W_LAYER + WO_FO), M, D, DFF}; pg8::StaticOrder S; S.init(M, D, (int)gridDim.x, (int)blockIdx.x);
          pg8::EpiRes E{(const float*)KOUT(), KOUT(), WSP(const float, WS_MOD) + (size_t)l * BATCH * NMOD + 5120, ALPHA, WSP(const float, WS_STATS), KIN(I_LN1G) + (size_t)l * D, KIN(I_LN1B) + (size_t)l * D};
          pg8::gemm_phase<pg8::EpiRes, pg8::StaticOrder, true, true>(LDS_P, g, S, E); }
        GSYNC();
        { PHASE_IDS();
          if (l + 1 < DEPTH) { const float* modn = WSP(const float, WS_MOD) + (size_t)(l + 1) * BATCH * NMOD;
              row_pass<true, true, false>(KOUT(), KOUT(), WSP(float, WS_STATS), WSP(bf16, WS_H), KIN(I_LN2G) + (size_t)l * D, KIN(I_LN2B) + (size_t)l * D, modn + 0, modn + 1024, gw, NGW, lane); }
          else row_pass<true, false, true>(KOUT(), KOUT(), nullptr, nullptr, KIN(I_LN2G) + (size_t)l * D, KIN(I_LN2B) + (size_t)l * D, nullptr, nullptr, gw, NGW, lane); }
        if (l + 1 < DEPTH) GSYNC();
    }
}

extern "C" void kernel_launch(void* const* d_in, const int* in_sizes, int n_in, void* d_out, int out_size, void* d_ws, size_t ws_size, hipStream_t stream) {
    static int grid = 0;
    if (grid == 0) {
        if (n_in != 24 || out_size != M * D || ws_size < WS_END) { fprintf(stderr, "kernel_launch: unexpected problem (n_in %d out %d ws %zu)\n", n_in, out_size, ws_size); grid = -1; return; }
        int dev = 0, cus = 0, per_cu = 0;
        hipGetDevice(&dev); hipDeviceGetAttribute(&cus, hipDeviceAttributeMultiprocessorCount, dev);
        if (hipFuncSetAttribute((const void*)fwd_megakernel, hipFuncAttributeMaxDynamicSharedMemorySize, LDS_BYTES) != hipSuccess) { fprintf(stderr, "kernel_launch: hipFuncSetAttribute failed\n"); grid = -1; return; }
        if (hipOccupancyMaxActiveBlocksPerMultiprocessor(&per_cu, (const void*)fwd_megakernel, NTHR, LDS_BYTES) != hipSuccess || per_cu < 1) { fprintf(stderr, "kernel_launch: occupancy query says %d\n", per_cu); per_cu = 1; }
        (void)hipGetLastError();
        grid = cus;
        fprintf(stderr, "kernel_launch: grid %d (cus %d, per_cu %d)\n", grid, cus, per_cu);
    }
    if (grid < 0) return;
    if (hipMemsetAsync(d_ws, 0, 65536, stream) != hipSuccess) { fprintf(stderr, "kernel_launch: memset of the barrier words failed\n"); return; }
    Args a{};
    for (int i = 0; i < 24; ++i) a.in[i] = (const float*)d_in[i];
    a.out = (float*)d_out; a.ws = (unsigned char*)d_ws;
    void* args[] = {&a};
    hipError_t e = hipLaunchCooperativeKernel((const void*)fwd_megakernel, dim3(grid), dim3(NTHR), args, LDS_BYTES, stream);
    if (e != hipSuccess) fprintf(stderr, "kernel_launch: cooperative launch failed: %s\n", hipGetErrorString(e));
}
```

```cpp
#include <hip/hip_runtime.h>
#include <hip/hip_cooperative_groups.h>
#include <cstdio>
#include <cstdint>
namespace cg = cooperative_groups;
typedef _Float16 hf2_t __attribute__((ext_vector_type(2)));
typedef float ff2_t __attribute__((ext_vector_type(2)));
__device__ __forceinline__ unsigned pkh2(float lo, float hi) { ff2_t v = {lo, hi}; hf2_t h = __builtin_convertvector(v, hf2_t); return __builtin_bit_cast(unsigned, h); }
__device__ __forceinline__ ff2_t uph2(unsigned w) { hf2_t h = __builtin_bit_cast(hf2_t, w); return __builtin_convertvector(h, ff2_t); }
namespace pg8 {
#define PG8_LAS __attribute__((address_space(3)))
typedef unsigned short bf16_t;
typedef short bf16x8 __attribute__((ext_vector_type(8)));
typedef float f32x4 __attribute__((ext_vector_type(4)));
typedef unsigned u32x4 __attribute__((ext_vector_type(4)));
constexpr int BM = 256, BK = 64, HALF = 128, HTB = HALF * BK * 2  , STAGE_BYTES = 8 * HTB, NXCD = 8, WGM = 8;

__host__ __device__ __forceinline__ int lds_byte(int r, int c) { const int st = (r >> 4) * 2 + (c >> 5), rr = r & 15, cc = c & 31, ob = rr * 64 + cc * 2; return st * 1024 + (ob ^ (((ob >> 9) & 1) << 5)); }
__host__ __device__ __forceinline__ void stage_rc(int b, int& R, int& C) { const int st = b / 1024, sb = b % 1024, swz = sb ^ (((sb >> 9) & 1) << 5); R = (st >> 1) * 16 + swz / 64; C = (st & 1) * 32 + (swz % 64) / 2; }
__host__ __device__ __forceinline__ int perm32(int rho) { const int n = rho >> 4, i = rho & 15; return 8 * (i >> 2) + 4 * n + (i & 3); }

struct Unit { int pm, pn; };
struct Gemm { const bf16_t* A; const bf16_t* Bt; int M, N, K; };

struct StaticOrder {
    int nM, nN, nwg, G, c;
    __host__ __device__ void init(int M, int N, int G_, int c_) { nM = M / BM; nN = N / BM; nwg = nM * nN; G = G_; c = c_; }
    __host__ __device__ bool next(int i, Unit& u) const {
        const long L = (long)i * G + c; if (L >= nwg) return false;
        int wgid = (int)L; { const int q = nwg / NXCD, r = nwg % NXCD, xcd = wgid % NXCD, off = wgid / NXCD; wgid = (xcd < r ? xcd * (q + 1) : r * (q + 1) + (xcd - r) * q) + off; }
        const int nig = WGM * nN, gid = wgid / nig, fm = gid * WGM, gsz = (nM - fm) < WGM ? (nM - fm) : WGM;
        u.pm = fm + ((wgid % nig) % gsz); u.pn = (wgid % nig) / gsz; return true;
    }
    __device__ __forceinline__ void a_ready(const Unit&) const {}
    __device__ __forceinline__ void done(const Unit&) const {}
};

__device__ __forceinline__ unsigned cvt_pk_bf16(float lo, float hi) { unsigned r; asm volatile("v_cvt_pk_bf16_f32 %0, %1, %2" : "=v"(r) : "v"(lo), "v"(hi)); return r; }
struct EpiBf16 {
    static constexpr bool PERM = true, AFTER_DRAIN = false;
    bf16_t* O; int ldc;
    __device__ __forceinline__ void operator()(const f32x4 (&acc)[2][2][4][2], const Unit& u, int wr, int wc, int fr, int fq) const {
        const int row0 = u.pm * BM + wr * 64 + fr; const int col0 = u.pn * BM + wc * 32 + 8 * fq;
#pragma unroll
        for (int ai = 0; ai < 2; ++ai)
#pragma unroll
            for (int m = 0; m < 4; ++m) { bf16_t* rowp = O + (size_t)(row0 + ai * HALF + m * 16) * ldc + col0;
#pragma unroll
                for (int bj = 0; bj < 2; ++bj) { const f32x4 v0 = acc[ai][bj][m][0], v1 = acc[ai][bj][m][1];
                    u32x4 w; w.x = cvt_pk_bf16(v0[0], v0[1]); w.y = cvt_pk_bf16(v0[2], v0[3]); w.z = cvt_pk_bf16(v1[0], v1[1]); w.w = cvt_pk_bf16(v1[2], v1[3]);
                    *(u32x4*)(rowp + bj * HALF) = w; } }
    }
};
template <bool XF32> struct EpiRes {
    static constexpr bool PERM = true, AFTER_DRAIN = false;
    const void* xsrc; bf16_t* zdst; const float* gt; float alpha;
    __device__ __forceinline__ void operator()(const f32x4 (&acc)[2][2][4][2], const Unit& u, int wr, int wc, int fr, int fq) const {
        const int row0 = u.pm * BM + wr * 64 + fr; const int col0 = u.pn * BM + wc * 32 + 8 * fq;
        const float* gtb = gt + (size_t)(u.pm >> 5) * 6144 + col0;
        f32x4 g[2][2];
#pragma unroll
        for (int bj = 0; bj < 2; ++bj)
#pragma unroll
            for (int n = 0; n < 2; ++n) g[bj][n] = *(const f32x4*)(gtb + bj * HALF + 4 * n) + 1.0f;
#pragma unroll
        for (int ai = 0; ai < 2; ++ai)
#pragma unroll
            for (int m = 0; m < 4; ++m) { const size_t ro = (size_t)(row0 + ai * HALF + m * 16) * 1024 + col0;
#pragma unroll
                for (int bj = 0; bj < 2; ++bj) { const size_t o = ro + bj * HALF;
                    f32x4 x0, x1;
                    if (XF32) { x0 = *(const f32x4*)((const float*)xsrc + o); x1 = *(const f32x4*)((const float*)xsrc + o + 4); }
                    else { const u32x4 xw = *(const u32x4*)((const bf16_t*)xsrc + o); const ff2_t a0 = uph2(xw.x), a1 = uph2(xw.y), a2 = uph2(xw.z), a3 = uph2(xw.w);
                        x0 = (f32x4){a0.x, a0.y, a1.x, a1.y}; x1 = (f32x4){a2.x, a2.y, a3.x, a3.y}; }
                    const f32x4 z0 = x0 * alpha + g[bj][0] * acc[ai][bj][m][0], z1 = x1 * alpha + g[bj][1] * acc[ai][bj][m][1];
                    u32x4 w; w.x = pkh2(z0[0], z0[1]); w.y = pkh2(z0[2], z0[3]); w.z = pkh2(z1[0], z1[1]); w.w = pkh2(z1[2], z1[3]);
                    *(u32x4*)(zdst + o) = w; } }
    }
};
struct EpiSwiGLU {
    static constexpr bool PERM = true, AFTER_DRAIN = false;
    bf16_t* O; int ldc;
    __device__ __forceinline__ void operator()(const f32x4 (&acc)[2][2][4][2], const Unit& u, int wr, int wc, int fr, int fq) const {
        const int row0 = u.pm * BM + wr * 64 + fr; const int col0 = u.pn * HALF + wc * 32 + 8 * fq;
#pragma unroll
        for (int ai = 0; ai < 2; ++ai)
#pragma unroll
            for (int m = 0; m < 4; ++m) { bf16_t* rowp = O + (size_t)(row0 + ai * HALF + m * 16) * ldc + col0;
                float r[8];
#pragma unroll
                for (int n = 0; n < 2; ++n)
#pragma unroll
                    for (int i = 0; i < 4; ++i) { const float gv = acc[ai][0][m][n][i], uv = acc[ai][1][m][n][i];
                        r[4 * n + i] = gv * __builtin_amdgcn_rcpf(1.0f + __expf(-gv)) * uv; }
                u32x4 w; w.x = cvt_pk_bf16(r[0], r[1]); w.y = cvt_pk_bf16(r[2], r[3]); w.z = cvt_pk_bf16(r[4], r[5]); w.w = cvt_pk_bf16(r[6], r[7]);
                *(u32x4*)rowp = w; }
    }
};

template <class Epi, class Sched, bool ALIGN_EPI = false, bool SP2 = false>
__device__ __forceinline__ void gemm_phase(PG8_LAS unsigned char* lds, const Gemm g, const Sched& S, const Epi& E) {
    int tid_ = threadIdx.x; asm volatile("" : "+v"(tid_));
    const int tid = tid_, wid = __builtin_amdgcn_readfirstlane(tid >> 6), lane = tid & 63, wr = wid >> 2, wc = wid & 3, fr = lane & 15, fq = lane >> 4;
    int K_ = g.K; asm volatile("" : "+s"(K_));
    const int K = K_, nt = K / BK;
    unsigned voffA[2], voffB[2];
#pragma unroll
    for (int i = 0; i < 2; ++i) { int R, C; stage_rc(tid * 16 + i * 8192, R, C); const int Rb = Epi::PERM ? ((R & ~31) + perm32(R & 31)) : R;
        voffA[i] = (unsigned)(R * K + C) * 2u; voffB[i] = (unsigned)(Rb * K + C) * 2u; }
    const size_t kstep = (size_t)(BK * 2);
    const size_t hstep = (size_t)HALF * K * 2;
    const size_t tstep = 2 * hstep;
    const unsigned ldsw = (unsigned)wid * 1024u;
    const int aoff = lds_byte(wr * 64 + fr, fq * 8), boff = lds_byte(wc * 32 + fr, fq * 8);
#define PG8_SA(b, h) (((b) * 2 + (h)) * HTB)
#define PG8_SB(b, h) ((4 + (b) * 2 + (h)) * HTB)
#define PG8_STAGE(bufoff, gbase, voff) do { _Pragma("unroll") for (int _i = 0; _i < 2; ++_i) \
        __builtin_amdgcn_global_load_lds((const unsigned*)((const char*)(gbase) + (voff)[_i]), (PG8_LAS unsigned*)(lds + (bufoff) + ldsw + _i * 8192), 16, 0, 0); } while (0)
#define PG8_LDA(dst, b, h) do { _Pragma("unroll") for (int m = 0; m < 4; ++m) _Pragma("unroll") for (int k = 0; k < 2; ++k) dst[m][k] = *(const PG8_LAS bf16x8*)(lds + PG8_SA(b, h) + aoff + m * 2048 + k * 1024); } while (0)
#define PG8_LDB(dst, b, h) do { _Pragma("unroll") for (int n = 0; n < 2; ++n) _Pragma("unroll") for (int k = 0; k < 2; ++k) dst[n][k] = *(const PG8_LAS bf16x8*)(lds + PG8_SB(b, h) + boff + n * 2048 + k * 1024); } while (0)
#define PG8_MMA(ai, bj, At, Bt) do { __builtin_amdgcn_s_setprio(1); _Pragma("unroll") for (int m = 0; m < 4; ++m) _Pragma("unroll") for (int n = 0; n < 2; ++n) _Pragma("unroll") for (int k = 0; k < 2; ++k) \
        acc[ai][bj][m][n] = __builtin_amdgcn_mfma_f32_16x16x32_bf16(Bt[n][k], At[m][k], acc[ai][bj][m][n], 0, 0, 0); __builtin_amdgcn_s_setprio(0); } while (0)
#define PG8_WAIT_V(n) asm volatile("s_waitcnt vmcnt(" #n ")" ::: "memory")
#define PG8_WAIT_L(n) asm volatile("s_waitcnt lgkmcnt(" #n ")" ::: "memory")
#define PG8_BAR __builtin_amdgcn_s_barrier()
#define PG8_SCHED __builtin_amdgcn_sched_barrier(0)
    Unit cur, nxt; int ui = 0;
    if (!S.next(0, cur)) return;
    f32x4 acc[2][2][4][2];
#pragma unroll
    for (int a = 0; a < 2; ++a)
#pragma unroll
        for (int b = 0; b < 2; ++b)
#pragma unroll
            for (int m = 0; m < 4; ++m)
#pragma unroll
                for (int n = 0; n < 2; ++n) acc[a][b][m][n] = (f32x4){0.f, 0.f, 0.f, 0.f};
    bf16x8 At[4][2], B0[2][2], B1[2][2];
    const char* cA = (const char*)g.A + (size_t)cur.pm * tstep; const char* cB = (const char*)g.Bt + (size_t)cur.pn * tstep;
    S.a_ready(cur);
    if constexpr (SP2) {
        PG8_STAGE(PG8_SB(0, 0), cB, voffB); PG8_STAGE(PG8_SB(0, 1), cB + hstep, voffB); PG8_STAGE(PG8_SA(0, 0), cA, voffA); PG8_STAGE(PG8_SA(0, 1), cA + hstep, voffA);
        if (wr == 1) PG8_BAR;
        PG8_WAIT_V(2); PG8_BAR;
        PG8_STAGE(PG8_SB(1, 0), cB + kstep, voffB); PG8_STAGE(PG8_SA(1, 0), cA + kstep, voffA); PG8_STAGE(PG8_SB(1, 1), cB + hstep + kstep, voffB);
        PG8_WAIT_V(6); PG8_BAR;
    } else {
        PG8_STAGE(PG8_SB(0, 0), cB, voffB); PG8_STAGE(PG8_SA(0, 0), cA, voffA); PG8_STAGE(PG8_SB(0, 1), cB + hstep, voffB); PG8_STAGE(PG8_SA(0, 1), cA + hstep, voffA);
        if (wr == 1) PG8_BAR;
        PG8_WAIT_V(4); PG8_BAR;
        PG8_STAGE(PG8_SB(1, 0), cB + kstep, voffB); PG8_STAGE(PG8_SA(1, 0), cA + kstep, voffA); PG8_STAGE(PG8_SB(1, 1), cB + hstep + kstep, voffB);
        PG8_WAIT_V(6); PG8_BAR;
    }
    for (;;) {
        const bool has_next = S.next(ui + 1, nxt);
        const char* nA = has_next ? (const char*)g.A + (size_t)nxt.pm * tstep : cA; const char* nB = has_next ? (const char*)g.Bt + (size_t)nxt.pn * tstep : cB;
        for (int t = 0; t < nt; t += 2) {
            const bool last = (t == nt - 2);
            const char* a1 = cA + (size_t)(t + 1) * kstep;
            const char* a2 = last ? nA : cA + (size_t)(t + 2) * kstep; const char* b2 = last ? nB : cB + (size_t)(t + 2) * kstep;
            const char* a3 = a2 + kstep; const char* b3 = b2 + kstep;
            if (last && has_next) S.a_ready(nxt);
            if constexpr (SP2) {
            PG8_LDB(B0, 0, 0); PG8_LDB(B1, 0, 1); PG8_SCHED; PG8_LDA(At, 0, 0); PG8_STAGE(PG8_SA(1, 1), a1 + hstep, voffA);
            PG8_WAIT_V(8); PG8_WAIT_L(0); PG8_BAR; PG8_MMA(0, 0, At, B0); PG8_MMA(0, 1, At, B1); PG8_BAR; PG8_SCHED;
            PG8_LDA(At, 0, 1); PG8_STAGE(PG8_SB(0, 0), b2, voffB); PG8_STAGE(PG8_SB(0, 1), b2 + hstep, voffB); PG8_STAGE(PG8_SA(0, 0), a2, voffA);
            PG8_WAIT_V(8); PG8_WAIT_L(0); PG8_BAR; PG8_MMA(1, 0, At, B0); PG8_MMA(1, 1, At, B1); PG8_BAR; PG8_SCHED;
            PG8_LDB(B0, 1, 0); PG8_LDB(B1, 1, 1); PG8_SCHED; PG8_LDA(At, 1, 0); PG8_STAGE(PG8_SA(0, 1), a2 + hstep, voffA);
            PG8_WAIT_V(8); PG8_WAIT_L(0); PG8_BAR; PG8_MMA(0, 0, At, B0); PG8_MMA(0, 1, At, B1); PG8_BAR; PG8_SCHED;
            PG8_LDA(At, 1, 1); PG8_STAGE(PG8_SB(1, 0), b3, voffB); PG8_STAGE(PG8_SB(1, 1), b3 + hstep, voffB); PG8_STAGE(PG8_SA(1, 0), a3, voffA);
            PG8_WAIT_V(8); PG8_WAIT_L(0); PG8_BAR; PG8_MMA(1, 0, At, B0); PG8_MMA(1, 1, At, B1); PG8_BAR; PG8_SCHED;
            } else {
            PG8_LDB(B0, 0, 0); PG8_SCHED; PG8_LDA(At, 0, 0); PG8_STAGE(PG8_SA(1, 1), a1 + hstep, voffA);
            PG8_WAIT_L(8); PG8_BAR; PG8_WAIT_L(0); PG8_MMA(0, 0, At, B0); PG8_BAR; PG8_SCHED;
            PG8_LDB(B1, 0, 1); PG8_STAGE(PG8_SB(0, 0), b2, voffB);
            PG8_BAR; PG8_WAIT_L(0); PG8_MMA(0, 1, At, B1); PG8_BAR;
            PG8_LDA(At, 0, 1); PG8_STAGE(PG8_SA(0, 0), a2, voffA);
            PG8_BAR; PG8_WAIT_L(0); PG8_MMA(1, 0, At, B0); PG8_BAR; PG8_SCHED;
            PG8_STAGE(PG8_SB(0, 1), b2 + hstep, voffB);
            PG8_WAIT_V(6); PG8_BAR; PG8_MMA(1, 1, At, B1); PG8_BAR;
            PG8_LDB(B0, 1, 0); PG8_SCHED; PG8_LDA(At, 1, 0); PG8_STAGE(PG8_SA(0, 1), a2 + hstep, voffA);
            PG8_WAIT_L(8); PG8_BAR; PG8_WAIT_L(0); PG8_MMA(0, 0, At, B0); PG8_BAR; PG8_SCHED;
            PG8_LDB(B1, 1, 1); PG8_STAGE(PG8_SB(1, 0), b3, voffB);
            PG8_BAR; PG8_WAIT_L(0); PG8_MMA(0, 1, At, B1); PG8_BAR;
            PG8_LDA(At, 1, 1); PG8_STAGE(PG8_SA(1, 0), a3, voffA);
            PG8_BAR; PG8_WAIT_L(0); PG8_MMA(1, 0, At, B0); PG8_BAR; PG8_SCHED;
            PG8_STAGE(PG8_SB(1, 1), b3 + hstep, voffB);
            PG8_WAIT_V(6); PG8_BAR; PG8_MMA(1, 1, At, B1); PG8_BAR;
            }
        }
        if constexpr (ALIGN_EPI) { if (wr == 0) PG8_BAR; }
        if constexpr (!Epi::AFTER_DRAIN) { E(acc, cur, wr, wc, fr, fq); S.done(cur); }
        if (!has_next) break;
#pragma unroll
        for (int a = 0; a < 2; ++a)
#pragma unroll
            for (int b = 0; b < 2; ++b)
#pragma unroll
                for (int m = 0; m < 4; ++m)
#pragma unroll
                    for (int n = 0; n < 2; ++n) acc[a][b][m][n] = (f32x4){0.f, 0.f, 0.f, 0.f};
        cur = nxt; cA = nA; cB = nB; ++ui;
        if constexpr (ALIGN_EPI) { if (wr == 1) PG8_BAR; }
    }
    PG8_WAIT_V(0);
    if constexpr (!ALIGN_EPI) { if (wr == 0) PG8_BAR; }
    PG8_BAR;
    if constexpr (Epi::AFTER_DRAIN) { E.fused(acc, cur, wr, wc, fr, fq, lds, wid, lane); S.done(cur); }
#undef PG8_SA
#undef PG8_SB
#undef PG8_STAGE
#undef PG8_LDA
#undef PG8_LDB
#undef PG8_MMA
#undef PG8_WAIT_V
#undef PG8_WAIT_L
#undef PG8_BAR
#undef PG8_SCHED
}
}
constexpr int BATCH = 4, SEQ = 8192, D = 1024, DEPTH = 4, M = BATCH * SEQ;
constexpr int HS = 64, NH = 8, DFF = 2816, NIN = 3328, SHIFT0 = 1536, NLK = 256, NLN = 1536, NMOD = 6144;
constexpr float ALPHA = 1.681792830507429f;
constexpr float LN_EPS = 1e-5f, GN_EPS = 64e-5f;
constexpr int NWAVES = 8, NTHR = 512, LDS_BYTES = 147456;
constexpr size_t MiB = 1u << 20;
constexpr size_t WS_MOD = 1 * MiB;
constexpr size_t WS_W = 2 * MiB, W_LAYER = 25 * MiB + 768 * 1024;
constexpr size_t WO_IN = 0, WO_LORA = 6 * MiB + 512 * 1024, WO_OUT = WO_LORA + 768 * 1024, WO_FI = WO_OUT + 2 * MiB, WO_FO = WO_FI + 11 * MiB;
constexpr size_t WS_H = 106 * MiB;
constexpr size_t WS_LORA = 106 * MiB;
constexpr size_t WS_XZ = 202 * MiB;
constexpr size_t WS_P = 266 * MiB;
constexpr size_t WS_ACT = 474 * MiB;
constexpr size_t WS_END = 490 * MiB;
static_assert(WO_FO + (size_t)D * DFF * 2 == W_LAYER && WS_W + DEPTH * W_LAYER <= WS_H && WS_LORA + (size_t)M * NLN * 2 <= WS_XZ && WS_P + (size_t)M * NIN * 2 <= WS_ACT, "ws map");

typedef unsigned short bf16;
typedef float f32x4 __attribute__((ext_vector_type(4)));
typedef unsigned u32x4 __attribute__((ext_vector_type(4)));
typedef unsigned u32x2 __attribute__((ext_vector_type(2)));
#define LAS __attribute__((address_space(3)))
__device__ __forceinline__ unsigned f2bf(float f) { unsigned u = __builtin_bit_cast(unsigned, f); return (u + 0x7fffu + ((u >> 16) & 1u)) >> 16; }
__device__ __forceinline__ unsigned pk2(float lo, float hi) { return f2bf(lo) | (f2bf(hi) << 16); }
__device__ __forceinline__ float bf2f(unsigned short v) { return __builtin_bit_cast(float, (unsigned)v << 16); }
__device__ __forceinline__ float bflo(unsigned w) { return __builtin_bit_cast(float, w << 16); }
__device__ __forceinline__ float bfhi(unsigned w) { return __builtin_bit_cast(float, w & 0xffff0000u); }
__device__ __forceinline__ float sigmoidf_(float x) { return __builtin_amdgcn_rcpf(1.0f + __expf(-x)); }
__device__ __forceinline__ float wave_sum(float v) {
#pragma unroll
    for (int o = 1; o < 64; o <<= 1) v += __shfl_xor(v, o);
    return v;
}
template <int CTRL> __device__ __forceinline__ float dpp_f(float v) { return __builtin_bit_cast(float, __builtin_amdgcn_update_dpp(0, __builtin_bit_cast(int, v), CTRL, 0xf, 0xf, true)); }
__device__ __forceinline__ float sum8(float v) { v += dpp_f<0xB1>(v); v += dpp_f<0x4E>(v); v += dpp_f<0x141>(v); return v; }

struct Args { const float* in[24]; float* out; unsigned char* ws; };
__device__ __forceinline__ const float* karg_in(int i) {
    const unsigned char __attribute__((address_space(4)))* kp = (const unsigned char __attribute__((address_space(4)))*)__builtin_amdgcn_kernarg_segment_ptr();
    asm volatile("" : "+s"(kp));
    return *(const float* const __attribute__((address_space(4)))*)(kp + 8 * i);
}
__device__ __forceinline__ unsigned char* karg_ptr(int i) { return (unsigned char*)karg_in(i); }
#define KIN(i) karg_in(i)
#define KOUT() ((float*)karg_ptr(24))
#define KWS() (karg_ptr(25))
enum { I_X = 0, I_C, I_WMOD, I_BMOD, I_WIN, I_CONVW, I_MU, I_W0, I_WDU, I_A0, I_AUP, I_GUP, I_KK, I_KA, I_RK, I_LNXG, I_LNXB, I_WOUT, I_LN1G, I_LN1B, I_WFI, I_WFO, I_LN2G, I_LN2B };

__device__ __forceinline__ void transpose_item(const float* W, int K, int N, bf16* WT, int mode, float* scr, int item, int lane) {
    const int nblk = N / 32, kb = item / nblk, nb = item % nblk, k0 = 64 * kb, n0 = 32 * nb;
#pragma unroll 8
    for (int i = 0; i < 32; ++i) { const int kk = 2 * i + (lane >> 5); scr[kk * 33 + (lane & 31)] = W[(size_t)(k0 + kk) * N + n0 + (lane & 31)]; }
    asm volatile("s_waitcnt lgkmcnt(0)" ::: "memory");
    int d0 = n0;
    if (mode == 1) { const int bj = n0 / DFF, rem = n0 % DFF; d0 = 256 * (rem / 128) + 128 * bj + (rem % 128); }
    const int c = lane & 7;
#pragma unroll
    for (int j = 0; j < 4; ++j) { const int n = (lane >> 3) + 8 * j; const float* s = scr + (8 * c) * 33 + n;
        u32x4 o; o.x = pk2(s[0 * 33], s[1 * 33]); o.y = pk2(s[2 * 33], s[3 * 33]); o.z = pk2(s[4 * 33], s[5 * 33]); o.w = pk2(s[6 * 33], s[7 * 33]);
        *(u32x4*)(WT + (size_t)(d0 + n) * K + k0 + 8 * c) = o; }
    asm volatile("s_waitcnt lgkmcnt(0)" ::: "memory");
}

__device__ __forceinline__ void p0_weights(const Args& a, unsigned char* lds_g, int gw, int NGW, int wave, int lane) {
    float* scr = (float*)(lds_g + 32768 + wave * 8704);
    constexpr int I_IN = 16 * 104, I_OUT = 16 * 32, I_FI = 16 * 176, I_FO = 44 * 32, I_L = I_IN + I_OUT + I_FI + I_FO;
    for (int it = gw; it < DEPTH * I_L; it += NGW) {
        const int l = it / I_L; int r = it % I_L; unsigned char* wl = KWS() + WS_W + (size_t)l * W_LAYER;
        if (r < I_IN) { transpose_item(KIN(I_WIN) + (size_t)l * D * NIN, D, NIN, (bf16*)(wl + WO_IN), 0, scr, r, lane); continue; } r -= I_IN;
        if (r < I_OUT) { transpose_item(KIN(I_WOUT) + (size_t)l * D * D, D, D, (bf16*)(wl + WO_OUT), 0, scr, r, lane); continue; } r -= I_OUT;
        if (r < I_FI) { transpose_item(KIN(I_WFI) + (size_t)l * D * 2 * DFF, D, 2 * DFF, (bf16*)(wl + WO_FI), 1, scr, r, lane); continue; } r -= I_FI;
        transpose_item(KIN(I_WFO) + (size_t)l * DFF * D, DFF, D, (bf16*)(wl + WO_FO), 0, scr, r, lane);
    }
    const int gt = gw * 64 + lane, NGT = NGW * 64;
    for (int ch = gt; ch < DEPTH * NLN * 32; ch += NGT) {
        const int l = ch / (NLN * 32), rr = ch % (NLN * 32), n = rr / 32, k0 = 8 * (rr % 32), seg = n / 512, nn = n % 512;
        const float* src = nullptr;
        if (seg == 0 && k0 < 64) src = KIN(I_WDU) + (size_t)l * 64 * 512 + (size_t)k0 * 512 + nn;
        else if (seg == 1 && k0 >= 64 && k0 < 128) src = KIN(I_AUP) + (size_t)l * 64 * 512 + (size_t)(k0 - 64) * 512 + nn;
        else if (seg == 2 && k0 >= 128) src = KIN(I_GUP) + (size_t)l * 128 * 512 + (size_t)(k0 - 128) * 512 + nn;
        u32x4 o = (u32x4){0u, 0u, 0u, 0u};
        if (src) { o.x = pk2(src[0], src[512]); o.y = pk2(src[1024], src[1536]); o.z = pk2(src[2048], src[2560]); o.w = pk2(src[3072], src[3584]); }
        *(u32x4*)((bf16*)(KWS() + WS_W + (size_t)l * W_LAYER + WO_LORA) + (size_t)n * NLK + k0) = o;
    }
}
__device__ __forceinline__ void p0_mod(const Args& a, unsigned char* lds_g, int tid, int wave, int lane) {
    float* sc = (float*)lds_g;
    float* red = sc + 4096;
    const float* c = KIN(I_C);
    for (int i = tid; i < BATCH * D; i += NTHR) { const float v = c[i]; sc[i] = v / (1.0f + __expf(-v)); }
    __syncthreads();
    float* MOD = (float*)(KWS() + WS_MOD);
    for (int item = blockIdx.x; item < DEPTH * 96; item += gridDim.x) {
        const int l = item / 96, jc = item % 96;
        const float* wp = KIN(I_WMOD) + ((size_t)l * D + wave * 128) * NMOD + jc * 64 + lane;
        float a0 = 0.f, a1 = 0.f, a2 = 0.f, a3 = 0.f;
#pragma unroll 8
        for (int i = 0; i < 128; ++i) { const float w = wp[(size_t)i * NMOD]; const int ii = wave * 128 + i;
            a0 += sc[ii] * w; a1 += sc[1024 + ii] * w; a2 += sc[2048 + ii] * w; a3 += sc[3072 + ii] * w; }
        red[(wave * 4 + 0) * 64 + lane] = a0; red[(wave * 4 + 1) * 64 + lane] = a1; red[(wave * 4 + 2) * 64 + lane] = a2; red[(wave * 4 + 3) * 64 + lane] = a3;
        __syncthreads();
        if (tid < 256) { const int bb = tid >> 6, ln = tid & 63; float s = 0.f;
#pragma unroll
            for (int w = 0; w < 8; ++w) s += red[(w * 4 + bb) * 64 + ln];
            MOD[(size_t)(l * BATCH + bb) * NMOD + jc * 64 + ln] = s + KIN(I_BMOD)[(size_t)l * NMOD + jc * 64 + ln]; }
        __syncthreads();
    }
}
typedef float f32x2_t __attribute__((ext_vector_type(2)));
typedef __bf16 bf16x2_t __attribute__((ext_vector_type(2)));
__device__ __forceinline__ unsigned cvtpk(float lo, float hi) { f32x2_t v = {lo, hi}; bf16x2_t b = __builtin_convertvector(v, bf16x2_t); return __builtin_bit_cast(unsigned, b); }
template <int CTRL, int RMASK> __device__ __forceinline__ float dpp_m(float v) { return __builtin_bit_cast(float, __builtin_amdgcn_update_dpp(0, __builtin_bit_cast(int, v), CTRL, RMASK, 0xf, true)); }
__device__ __forceinline__ float wave_total(float v) {
    v += dpp_m<0x111, 0xf>(v); v += dpp_m<0x112, 0xf>(v); v += dpp_m<0x114, 0xf>(v); v += dpp_m<0x118, 0xf>(v);
    v += dpp_m<0x142, 0xa>(v);
    v += dpp_m<0x143, 0xc>(v);
    return __builtin_bit_cast(float, __builtin_amdgcn_readlane(__builtin_bit_cast(int, v), 63));
}
template <bool LN, bool WRITE_H, bool IN16, int XOUT> __device__ __forceinline__ void row_pass(const void* xin, void* xout, bf16* H, const float* lg, const float* lb, const float* modsh, const float* modsc, int gw, int NGW, int lane) {
    f32x4 nx[4]; u32x2 nw[4];
#define RP_LOAD(row) do { if (IN16) { const u32x2* xr_ = (const u32x2*)((const bf16*)xin + (size_t)(row) * D) + lane; _Pragma("unroll") for (int j_ = 0; j_ < 4; ++j_) nw[j_] = xr_[64 * j_]; } \
        else { const f32x4* xr_ = (const f32x4*)((const float*)xin + (size_t)(row) * D) + lane; _Pragma("unroll") for (int j_ = 0; j_ < 4; ++j_) nx[j_] = xr_[64 * j_]; } } while (0)
    if (gw < M) RP_LOAD(gw);
    for (int m = gw; m < M; m += NGW) {
        f32x4 v[4];
#pragma unroll
        for (int j = 0; j < 4; ++j) { if (IN16) { const ff2_t a0 = uph2(nw[j].x), a1 = uph2(nw[j].y); v[j] = (f32x4){a0.x, a0.y, a1.x, a1.y}; } else v[j] = nx[j]; }
        if (m + NGW < M) RP_LOAD(m + NGW);
        if (LN) {
            float s = 0.f;
#pragma unroll
            for (int j = 0; j < 4; ++j) s += (v[j].x + v[j].y) + (v[j].z + v[j].w);
            const float mean = wave_total(s) * (1.f / D); float s2 = 0.f;
#pragma unroll
            for (int j = 0; j < 4; ++j) { v[j] = v[j] - mean; s2 += (v[j].x * v[j].x + v[j].y * v[j].y) + (v[j].z * v[j].z + v[j].w * v[j].w); }
            const float rstd = 1.f / sqrtf(wave_total(s2) * (1.f / D) + LN_EPS);
#pragma unroll
            for (int j = 0; j < 4; ++j) { const f32x4 g = ((const f32x4*)lg)[lane + 64 * j], bb = ((const f32x4*)lb)[lane + 64 * j]; v[j] = v[j] * rstd * g + bb;
                if (XOUT == 2) ((f32x4*)((float*)xout + (size_t)m * D) + lane)[64 * j] = v[j];
                if (XOUT == 1) { u32x2 o; o.x = pkh2(v[j].x, v[j].y); o.y = pkh2(v[j].z, v[j].w); ((u32x2*)((bf16*)xout + (size_t)m * D) + lane)[64 * j] = o; } }
        }
        if (WRITE_H) {
            const int b = m / SEQ;
            const f32x4* sh = (const f32x4*)(modsh + (size_t)b * NMOD) + lane; const f32x4* sc = (const f32x4*)(modsc + (size_t)b * NMOD) + lane;
            u32x2* ho = (u32x2*)(H + (size_t)m * D) + lane;
#pragma unroll
            for (int j = 0; j < 4; ++j) { const f32x4 h = v[j] * (sc[64 * j] + 1.0f) + sh[64 * j]; u32x2 o; o.x = cvtpk(h.x, h.y); o.y = cvtpk(h.z, h.w); ho[64 * j] = o; }
        }
    }
#undef RP_LOAD
}
__device__ __forceinline__ void p2a_conv_act(const bf16* P, bf16* MIX, bf16* ACT, const float* convw, const float* mu, int gw, int NGW, int lane) {
    float cw[3][8];
#pragma unroll
    for (int k = 0; k < 3; ++k)
#pragma unroll
        for (int i = 0; i < 8; ++i) cw[k][i] = convw[k * 512 + lane * 8 + i];
    float mul[4];
#pragma unroll
    for (int i = 0; i < 4; ++i) mul[i] = mu[1536 + lane * 4 + i];
    for (int run = gw; run < M / 16; run += NGW) {
        const int m0 = run * 16, t0 = m0 % SEQ;
        float z1[8], z2[8], pl[4];
#pragma unroll
        for (int i = 0; i < 8; ++i) { z1[i] = 0.f; z2[i] = 0.f; }
#pragma unroll
        for (int i = 0; i < 4; ++i) pl[i] = 0.f;
        if (t0 > 0) {
            const bf16* p1 = P + (size_t)(m0 - 1) * NIN; const bf16* p2 = P + (size_t)(m0 - 2) * NIN;
            const u32x4 c1 = *(const u32x4*)(p1 + 512 + lane * 8), u1 = *(const u32x4*)(p1 + 1024 + lane * 8);
            const u32x4 c2 = *(const u32x4*)(p2 + 512 + lane * 8), u2 = *(const u32x4*)(p2 + 1024 + lane * 8);
#pragma unroll
            for (int q = 0; q < 4; ++q) { z1[2 * q] = bflo(c1[q]) * bflo(u1[q]); z1[2 * q + 1] = bfhi(c1[q]) * bfhi(u1[q]); z2[2 * q] = bflo(c2[q]) * bflo(u2[q]); z2[2 * q + 1] = bfhi(c2[q]) * bfhi(u2[q]); }
            const u32x2 l1 = *(const u32x2*)(p1 + 3072 + lane * 4);
            pl[0] = bflo(l1.x); pl[1] = bfhi(l1.x); pl[2] = bflo(l1.y); pl[3] = bfhi(l1.y);
        }
        u32x4 nbb, ncc, nuu; u32x2 nll;
        { const bf16* p0 = P + (size_t)m0 * NIN; nbb = *(const u32x4*)(p0 + lane * 8); ncc = *(const u32x4*)(p0 + 512 + lane * 8); nuu = *(const u32x4*)(p0 + 1024 + lane * 8); nll = *(const u32x2*)(p0 + 3072 + lane * 4); }
#pragma unroll 2
        for (int tt = 0; tt < 16; ++tt) {
            const u32x4 bb = nbb, cc = ncc, uu = nuu; const u32x2 ll = nll;
            if (tt + 1 < 16) { const bf16* p0 = P + (size_t)(m0 + tt + 1) * NIN;
                nbb = *(const u32x4*)(p0 + lane * 8); ncc = *(const u32x4*)(p0 + 512 + lane * 8); nuu = *(const u32x4*)(p0 + 1024 + lane * 8); nll = *(const u32x2*)(p0 + 3072 + lane * 4); }
            float z0[8], bg[8], y[8];
#pragma unroll
            for (int q = 0; q < 4; ++q) { z0[2 * q] = bflo(cc[q]) * bflo(uu[q]); z0[2 * q + 1] = bfhi(cc[q]) * bfhi(uu[q]); bg[2 * q] = bflo(bb[q]); bg[2 * q + 1] = bfhi(bb[q]); }
#pragma unroll
            for (int i = 0; i < 8; ++i) { y[i] = bg[i] * (cw[0][i] * z2[i] + cw[1][i] * z1[i] + cw[2][i] * z0[i]); z2[i] = z1[i]; z1[i] = z0[i]; }
            u32x4 o; o.x = pk2(y[0], y[1]); o.y = pk2(y[2], y[3]); o.z = pk2(y[4], y[5]); o.w = pk2(y[6], y[7]);
            *(u32x4*)(MIX + (size_t)(m0 + tt) * D + lane * 8) = o;
            float cur[4] = {bflo(ll.x), bfhi(ll.x), bflo(ll.y), bfhi(ll.y)}, av[4];
#pragma unroll
            for (int i = 0; i < 4; ++i) { const float xs = cur[i] + mul[i] * (pl[i] - cur[i]); pl[i] = cur[i];
                av[i] = (lane < 16) ? tanhf(xs) : ((lane < 32) ? xs : sigmoidf_(xs)); }
            u32x2 oa; oa.x = pk2(av[0], av[1]); oa.y = pk2(av[2], av[3]);
            *(u32x2*)(ACT + (size_t)(m0 + tt) * NLK + lane * 4) = oa;
        }
    }
}
typedef short s4v __attribute__((ext_vector_type(4)));
typedef LAS unsigned short LB;
constexpr int LDT = 24, LDJ = 72;
constexpr int SZ_J = 16 * LDJ * 2, SZ_C = 64 * LDT * 2, SZ_S = 16 * LDT * 2;
constexpr int SL_AT = 0, SL_QE = SL_AT + SZ_J, SL_BPT = SL_QE + SZ_J, SL_KET = SL_BPT + SZ_C, SL_VT = SL_KET + SZ_C, SL_WV = SL_VT + SZ_C, SL_PC = SL_WV + SZ_S, SL_BON = SL_PC + 256, SLOT_BYTES = SL_BON + 64;
constexpr int SC_BT = 0, SC_KT = SC_BT + SZ_J, SC_RT = SC_KT + SZ_J, SC_ATT = SC_RT + SZ_J, SC_BTT = SC_ATT + SZ_C, SC_NP = SC_BTT + SZ_C, SC_NPT = SC_NP + SZ_S, SC_TM = SC_NPT + SZ_S, SC_TT = SC_TM + SZ_S,
              SC_NAKT = SC_TT + SZ_S, SC_MRB = SC_NAKT + SZ_S, SC_X = SC_MRB + SZ_S, SCR_BYTES = SC_X + SZ_S;
constexpr int CK_SLOTS = 0, CK_SCR = 4 * SLOT_BYTES, CK_YBUF = CK_SCR + 4 * SCR_BYTES, CK_END = CK_YBUF + 64 * 64 * 2;
static_assert(SLOT_BYTES % 16 == 0 && SCR_BYTES % 16 == 0 && CK_END <= LDS_BYTES, "chunked-scan LDS map");
__device__ __forceinline__ f32x4 mm16(const LB* A, int lda, const LB* BT, int ldb, f32x4 acc, int c, int q) {
    const s4v a = *(const LAS s4v*)(A + c * lda + 4 * q);
    const s4v b = *(const LAS s4v*)(BT + c * ldb + 4 * q);
    return __builtin_amdgcn_mfma_f32_16x16x16bf16_1k(a, b, acc, 0, 0, 0);
}
__device__ __forceinline__ f32x4 mm64(const LB* A, const LB* BT, int c, int q) {
    f32x4 acc = {0.f, 0.f, 0.f, 0.f};
#pragma unroll
    for (int ks = 0; ks < 4; ++ks) acc = mm16(A + 16 * ks, LDJ, BT + 16 * ks, LDJ, acc, c, q);
    return acc;
}
__device__ __forceinline__ void stT(LB* O, int ldo, f32x4 v, int c, int q) { u32x2 w; w.x = cvtpk(v[0], v[1]); w.y = cvtpk(v[2], v[3]); *(LAS u32x2*)(O + c * ldo + 4 * q) = w; }
__device__ __forceinline__ void stN(LB* O, int ldo, f32x4 v, int c, int q) {
#pragma unroll
    for (int r = 0; r < 4; r += 2) { const unsigned w = cvtpk(v[r], v[r + 1]); O[(4 * q + r) * ldo + c] = (unsigned short)w; O[(4 * q + r + 1) * ldo + c] = (unsigned short)(w >> 16); }
}
__device__ __forceinline__ s4v bf4(f32x4 v) { u32x2 w; w.x = cvtpk(v[0], v[1]); w.y = cvtpk(v[2], v[3]); return __builtin_bit_cast(s4v, w); }

constexpr int NSEG = 8, SEG_SS = SEQ / 64 / NSEG;
template <int PASS> __device__ __forceinline__ void p3_chunked(int l, unsigned char* lds_g, const bf16* P, const bf16* LORA, bf16* MIX, float* SEG, int tid, int wave, int lane) {
    if (blockIdx.x >= BATCH * NH * NSEG) return;
    const int bh = blockIdx.x & 31, seg = blockIdx.x >> 5, b = bh >> 3, h = bh & 7;
    LAS unsigned char* lds = (LAS unsigned char*)lds_g;
    const int c = lane & 15, q = lane >> 4;
    const int hc = h * 64 + lane;
    const float* mu = KIN(I_MU) + (size_t)l * 1792;
    const float mu_r = mu[hc], mu_k = mu[512 + hc], mu_v = mu[1024 + hc];
    const float w0c = KIN(I_W0)[l * 512 + hc], a0c = KIN(I_A0)[l * 512 + hc], kkc = KIN(I_KK)[l * 512 + hc], kac = KIN(I_KA)[l * 512 + hc], rkc = KIN(I_RK)[l * 512 + hc];
    const float lgc = KIN(I_LNXG)[l * 512 + hc], lbc = KIN(I_LNXB)[l * 512 + hc];
    f32x4 Sreg[4], Greg[4];
#pragma unroll
    for (int T = 0; T < 4; ++T) { Sreg[T] = (f32x4){0.f, 0.f, 0.f, 0.f};
#pragma unroll
        for (int r = 0; r < 4; ++r) Greg[T][r] = (PASS == 1 && 16 * T + 4 * q + r == 16 * (wave & 3) + c) ? 1.0f : 0.0f; }
    if (PASS == 2 && wave < 4) {
        for (int s = 0; s < seg; ++s) {
            const float* Gt = SEG + ((size_t)(bh * NSEG + s) * 2 + 0) * 4096; const float* Ht = SEG + ((size_t)(bh * NSEG + s) * 2 + 1) * 4096;
            s4v sb[4];
#pragma unroll
            for (int T = 0; T < 4; ++T) sb[T] = bf4(Sreg[T]);
#pragma unroll
            for (int T2 = 0; T2 < 4; ++T2) {
                f32x4 acc;
#pragma unroll
                for (int r = 0; r < 4; ++r) acc[r] = Ht[(16 * T2 + 4 * q + r) * 64 + 16 * wave + c];
#pragma unroll
                for (int T = 0; T < 4; ++T) { const f32x4 gv = *(const f32x4*)(Gt + (16 * T2 + c) * 64 + 16 * T + 4 * q);
                    acc = __builtin_amdgcn_mfma_f32_16x16x16bf16_1k(bf4(gv), sb[T], acc, 0, 0, 0); }
                Sreg[T2] = acc;
            }
        }
    }
    const bf16* Pb = P + (size_t)b * SEQ * NIN + SHIFT0 + hc;
    const bf16* Lb = LORA + (size_t)b * SEQ * NLN + hc;
    const int pw = wave & 3, half = wave >> 2;
    unsigned short raw[8][5], rawp[3], rawlw[8], graw[8];
#define LOAD_RAW(ssn) do { const int tok0_ = 16 * (4 * (ssn) + pw) + 8 * half; \
        if (tok0_ > 0) { const bf16* pp_ = Pb + (size_t)(tok0_ - 1) * NIN; rawp[0] = pp_[0]; rawp[1] = pp_[512]; rawp[2] = pp_[1024]; } else { rawp[0] = 0; rawp[1] = 0; rawp[2] = 0; } \
        _Pragma("unroll") for (int t_ = 0; t_ < 8; ++t_) { const bf16* pc_ = Pb + (size_t)(tok0_ + t_) * NIN; const bf16* lc_ = Lb + (size_t)(tok0_ + t_) * NLN; \
            raw[t_][0] = pc_[0]; raw[t_][1] = pc_[512]; raw[t_][2] = pc_[1024]; raw[t_][3] = lc_[0]; raw[t_][4] = lc_[512]; \
            rawlw[t_] = half ? Lb[(size_t)(tok0_ - 8 + t_) * NLN] : (unsigned short)0; \
            if (PASS == 2) graw[t_] = Lb[((size_t)(ssn) * 64 + wave * 8 + t_) * NLN + 1024]; } } while (0)
    LOAD_RAW(seg * SEG_SS);
    for (int ss = seg * SEG_SS; ss < (seg + 1) * SEG_SS; ++ss) {
        unsigned short gcur[8];
#pragma unroll
        for (int i_ = 0; i_ < 8; ++i_) gcur[i_] = graw[i_];
        {
            LB* SL = (LB*)(lds + CK_SLOTS + pw * SLOT_BYTES); LB* SC = (LB*)(lds + CK_SCR + pw * SCR_BYTES);
            LB* sAt = SL + SL_AT / 2; LB* sVT = SL + SL_VT / 2; LAS float* sPC = (LAS float*)(SL + SL_PC / 2); LAS float* sBon = (LAS float*)(SL + SL_BON / 2);
            LB* cBt = SC + SC_BT / 2; LB* cKt = SC + SC_KT / 2; LB* cRt = SC + SC_RT / 2; LB* cATT = SC + SC_ATT / 2; LB* cBTT = SC + SC_BTT / 2;
            float pr = bf2f(rawp[0]), pk = bf2f(rawp[1]), pv = bf2f(rawp[2]), cs = 0.f;
            if (half) {
#pragma unroll
                for (int t = 0; t < 8; ++t) cs += 0.6065306597126334f * sigmoidf_(w0c + bf2f(rawlw[t]));
            }
            float ptp = __expf(-cs);
            unsigned pkA[4], pkB[4], pkV[4]; float loA = 0.f, loB = 0.f, loV = 0.f;
#pragma unroll
            for (int t8 = 0; t8 < 8; ++t8) {
                const int t = 8 * half + t8;
                const float cr = bf2f(raw[t8][0]), ck = bf2f(raw[t8][1]), cv = bf2f(raw[t8][2]), lw = bf2f(raw[t8][3]), la = bf2f(raw[t8][4]);
                const float r = cr + mu_r * (pr - cr), k = ck + mu_k * (pk - ck), v = cv + mu_v * (pv - cv);
                pr = cr; pk = ck; pv = cv;
                const float e = 0.6065306597126334f * sigmoidf_(w0c + lw);
                const float lr = sigmoidf_(a0c + la);
                const float kkv = k * kkc; const float n2 = wave_total(kkv * kkv);
                const float kk = kkv * __builtin_amdgcn_rsqf(fmaxf(n2, 1e-24f));
                const float k2 = k * (1.0f + (lr - 1.0f) * kac);
                const float bon = wave_total(r * k2 * rkc);
                const float pm1 = ptp; cs += e; const float pt = __expf(-cs), ipt = __builtin_amdgcn_rcpf(pt); ptp = pt;
                const float At_ = -kk * pm1, Bt_ = kk * lr * ipt, Kt_ = k2 * ipt, Rt_ = r * pt;
                { const unsigned ab = cvtpk(At_, Bt_), kr = cvtpk(Kt_, Rt_); sAt[t * LDJ + lane] = (unsigned short)ab; cBt[t * LDJ + lane] = (unsigned short)(ab >> 16); cKt[t * LDJ + lane] = (unsigned short)kr; cRt[t * LDJ + lane] = (unsigned short)(kr >> 16); }
                if (lane == 0) sBon[t] = bon;
                if (t8 & 1) { pkA[t8 >> 1] = cvtpk(loA, At_); pkB[t8 >> 1] = cvtpk(loB, Bt_); pkV[t8 >> 1] = cvtpk(loV, v); } else { loA = At_; loB = Bt_; loV = v; }
            }
            if (half) sPC[lane] = ptp;
            *(LAS u32x4*)(cATT + lane * LDT + 8 * half) = (u32x4){pkA[0], pkA[1], pkA[2], pkA[3]};
            *(LAS u32x4*)(cBTT + lane * LDT + 8 * half) = (u32x4){pkB[0], pkB[1], pkB[2], pkB[3]};
            *(LAS u32x4*)(sVT + lane * LDT + 8 * half) = (u32x4){pkV[0], pkV[1], pkV[2], pkV[3]};
            if (ss + 1 < (seg + 1) * SEG_SS) LOAD_RAW(ss + 1);
        }
        __syncthreads();
        if (wave < 4) {
            LB* SL = (LB*)(lds + CK_SLOTS + wave * SLOT_BYTES); LB* SC = (LB*)(lds + CK_SCR + wave * SCR_BYTES);
            LB* sAt = SL + SL_AT / 2; LB* sQe = SL + SL_QE / 2; LB* sBpT = SL + SL_BPT / 2; LB* sKeT = SL + SL_KET / 2; LB* sWv = SL + SL_WV / 2;
            LB* cBt = SC + SC_BT / 2; LB* cKt = SC + SC_KT / 2; LB* cRt = SC + SC_RT / 2; LB* cATT = SC + SC_ATT / 2; LB* cBTT = SC + SC_BTT / 2;
            LB* cNp = SC + SC_NP / 2; LB* cNpT = SC + SC_NPT / 2; LB* cTm = SC + SC_TM / 2; LB* cTT = SC + SC_TT / 2; LB* cNakT = SC + SC_NAKT / 2; LB* cMrb = SC + SC_MRB / 2; LB* cX = SC + SC_X / 2;
            f32x4 Nab = mm64(sAt, cBt, c, q), Nak = mm64(sAt, cKt, c, q), Mrb = mm64(cRt, cBt, c, q), Mrk = mm64(cRt, cKt, c, q);
#pragma unroll
            for (int r = 0; r < 4; ++r) { const int t = 4 * q + r; if (!(t > c)) { Nab[r] = 0.f; Nak[r] = 0.f; } if (!(t >= c)) { Mrb[r] = 0.f; Mrk[r] = 0.f; } }
            stN(cNp, LDT, Nab, c, q); stT(cNpT, LDT, Nab, c, q); stT(cNakT, LDT, Nak, c, q); stN(cMrb, LDT, Mrb, c, q);
            f32x4 Tr = Nab;
#pragma unroll
            for (int r = 0; r < 4; ++r) if (4 * q + r == c) Tr[r] += 1.0f;
#pragma unroll
            for (int it = 0; it < 3; ++it) {
                stN(cTm, LDT, Tr, c, q);
                const f32x4 N2 = mm16(cNp, LDT, cNpT, LDT, (f32x4){0.f, 0.f, 0.f, 0.f}, c, q);
                stN(cNp, LDT, N2, c, q); stT(cNpT, LDT, N2, c, q);
                Tr = mm16(cTm, LDT, cNpT, LDT, Tr, c, q);
            }
            stT(cTT, LDT, Tr, c, q);
            const f32x4 Xr = mm16(cMrb, LDT, cTT, LDT, (f32x4){0.f, 0.f, 0.f, 0.f}, c, q);
            stN(cX, LDT, Xr, c, q);
            if (PASS == 2) { const f32x4 Wv = mm16(cX, LDT, cNakT, LDT, Mrk, c, q); stN(sWv, LDT, Wv, c, q); }
#pragma unroll
            for (int jt = 0; jt < 4; ++jt) {
                f32x4 a0;
#pragma unroll
                for (int r = 0; r < 4; ++r) a0[r] = bf2f(cRt[(4 * q + r) * LDJ + 16 * jt + c]);
                if (PASS == 2) { const f32x4 Qe = mm16(cX, LDT, cATT + 16 * jt * LDT, LDT, a0, c, q);
                    stN(sQe + 16 * jt, LDJ, Qe, c, q); }
                const f32x4 Bp = mm16(cTT, LDT, cBTT + 16 * jt * LDT, LDT, (f32x4){0.f, 0.f, 0.f, 0.f}, c, q);
                stT(sBpT + 16 * jt * LDT, LDT, Bp, c, q);
                f32x4 k0;
#pragma unroll
                for (int r = 0; r < 4; ++r) k0[r] = bf2f(cKt[(4 * q + r) * LDJ + 16 * jt + c]);
                const f32x4 Ke = mm16(cNakT, LDT, sBpT + 16 * jt * LDT, LDT, k0, c, q);
                stT(sKeT + 16 * jt * LDT, LDT, Ke, c, q);
            }
        }
        __syncthreads();
        if (wave < 4) {
            LB* ybuf = (LB*)(lds + CK_YBUF);
#pragma unroll 1
            for (int cl = 0; cl < 4; ++cl) {
                LB* SL = (LB*)(lds + CK_SLOTS + cl * SLOT_BYTES);
                LB* sAt = SL + SL_AT / 2; LB* sQe = SL + SL_QE / 2; LB* sBpT = SL + SL_BPT / 2; LB* sKeT = SL + SL_KET / 2; LB* sVT = SL + SL_VT / 2; LB* sWv = SL + SL_WV / 2;
                LAS float* sPC = (LAS float*)(SL + SL_PC / 2);
                s4v sb[4], gb[4];
#pragma unroll
                for (int T = 0; T < 4; ++T) { sb[T] = bf4(Sreg[T]); gb[T] = bf4(Greg[T]); }
                const s4v vb = *(const LAS s4v*)(sVT + (16 * wave + c) * LDT + 4 * q);
                f32x4 X = {0.f, 0.f, 0.f, 0.f}, Y = {0.f, 0.f, 0.f, 0.f}, XG = {0.f, 0.f, 0.f, 0.f};
#pragma unroll
                for (int T = 0; T < 4; ++T) {
                    const s4v at = *(const LAS s4v*)(sAt + c * LDJ + 16 * T + 4 * q);
                    X = __builtin_amdgcn_mfma_f32_16x16x16bf16_1k(at, sb[T], X, 0, 0, 0);
                    if (PASS == 1) XG = __builtin_amdgcn_mfma_f32_16x16x16bf16_1k(at, gb[T], XG, 0, 0, 0);
                    if (PASS == 2) Y = __builtin_amdgcn_mfma_f32_16x16x16bf16_1k(*(const LAS s4v*)(sQe + c * LDJ + 16 * T + 4 * q), sb[T], Y, 0, 0, 0);
                }
                if (PASS == 2) Y = __builtin_amdgcn_mfma_f32_16x16x16bf16_1k(*(const LAS s4v*)(sWv + c * LDT + 4 * q), vb, Y, 0, 0, 0);
                const s4v xb = bf4(X), xgb = bf4(XG);
#pragma unroll
                for (int T = 0; T < 4; ++T) {
                    f32x4 s = Sreg[T];
                    const s4v bp = *(const LAS s4v*)(sBpT + (16 * T + c) * LDT + 4 * q);
                    s = __builtin_amdgcn_mfma_f32_16x16x16bf16_1k(bp, xb, s, 0, 0, 0);
                    s = __builtin_amdgcn_mfma_f32_16x16x16bf16_1k(*(const LAS s4v*)(sKeT + (16 * T + c) * LDT + 4 * q), vb, s, 0, 0, 0);
                    const f32x4 pc = *(const LAS f32x4*)(sPC + 16 * T + 4 * q);
                    Sreg[T] = s * pc;
                    if (PASS == 1) Greg[T] = __builtin_amdgcn_mfma_f32_16x16x16bf16_1k(bp, xgb, Greg[T], 0, 0, 0) * pc;
                }
                if (PASS == 2) {
#pragma unroll
                    for (int r = 0; r < 4; r += 2) { const unsigned w = cvtpk(Y[r], Y[r + 1]); ybuf[(cl * 16 + 4 * q + r) * 64 + 16 * wave + c] = (unsigned short)w; ybuf[(cl * 16 + 4 * q + r + 1) * 64 + 16 * wave + c] = (unsigned short)(w >> 16); }
                }
            }
        }
        __syncthreads();
        if (PASS == 2) {
            const LB* ybuf = (const LB*)(lds + CK_YBUF);
#pragma unroll
            for (int i = 0; i < 8; ++i) {
                const int tt = wave * 8 + i, cl = tt >> 4, t = tt & 15; const size_t tok = (size_t)ss * 64 + tt;
                const LB* SL = (const LB*)(lds + CK_SLOTS + cl * SLOT_BYTES);
                const float g = bf2f(gcur[i]);
                const float y = bf2f(ybuf[tt * 64 + lane]), v = bf2f(SL[SL_VT / 2 + lane * LDT + t]), bon = ((const LAS float*)(SL + SL_BON / 2))[t];
                const float mean = wave_total(y) * (1.f / 64.f); const float d = y - mean; const float var = wave_total(d * d) * (1.f / 64.f);
                const float yn = d * __builtin_amdgcn_rsqf(var + GN_EPS) * lgc + lbc;
                MIX[((size_t)b * SEQ + tok) * D + 512 + hc] = (bf16)f2bf((yn + bon * v) * g);
            }
        }
        if (PASS == 2) __syncthreads();
    }
    if (PASS == 1 && wave < 4) {
        float* Gt = SEG + ((size_t)(bh * NSEG + seg) * 2 + 0) * 4096; float* Ht = SEG + ((size_t)(bh * NSEG + seg) * 2 + 1) * 4096;
#pragma unroll
        for (int T = 0; T < 4; ++T)
#pragma unroll
            for (int r = 0; r < 4; ++r) { Gt[(16 * T + 4 * q + r) * 64 + 16 * wave + c] = Greg[T][r]; Ht[(16 * T + 4 * q + r) * 64 + 16 * wave + c] = Sreg[T][r]; }
    }
#undef LOAD_RAW
}

#define XB_TMO      128
#define XB_XCNT(j)  (256  + 64 * (j))
#define XB_XSUB(j)  (1280 + 64 * (j))
#define XB_XGEN(j)  (2304 + 64 * (j))
#define XB_TOP      3328
#define XB_TOPGEN   3392
#define XCD_BAR_WORDS 3456
#define XB_SPIN_CAP (1u << 18)

__device__ __forceinline__ unsigned xb_ld(unsigned* p)              { return __hip_atomic_load(p, __ATOMIC_RELAXED, __HIP_MEMORY_SCOPE_AGENT); }
__device__ __forceinline__ unsigned xb_add(unsigned* p, unsigned v) { return __hip_atomic_fetch_add(p, v, __ATOMIC_RELAXED, __HIP_MEMORY_SCOPE_AGENT); }
__device__ __forceinline__ unsigned xb_xcc_id() { return (unsigned)__builtin_amdgcn_s_getreg((3 << 11) | 20) & 0xFu; }
#define XB_SPIN(cond, bar) do { unsigned _sp = 0; while (cond) { __builtin_amdgcn_s_sleep(1); \
    if ((++_sp & 255u) == 0u) { if (xb_ld(&(bar)[XB_TMO])) break; if (_sp > XB_SPIN_CAP) { atomicAdd(&(bar)[XB_TMO], 1u); break; } } } } while (0)

struct XcdBarrier {
    unsigned* bar; unsigned x;
    volatile LAS unsigned* st;
};

__device__ __forceinline__ XcdBarrier xcd_barrier_post(unsigned* bar, volatile LAS unsigned* st) {
    XcdBarrier b; b.bar = bar; b.x = xb_xcc_id(); b.st = st;
    if (threadIdx.x == 0) (void)xb_add(&bar[XB_XCNT(b.x)], 1u);
    return b;
}
__device__ __forceinline__ void xcd_barrier_complete(unsigned* bar, unsigned x, unsigned& nloc, unsigned& nx) {
    const unsigned G = gridDim.x * gridDim.y * gridDim.z;
    unsigned sum, cnt, mine, sp = 0u;
    for (;;) {
        sum = 0u; cnt = 0u; mine = 0u;
#pragma unroll
        for (unsigned j = 0; j < 16; ++j) { const unsigned c = xb_ld(&bar[XB_XCNT(j)]); sum += c; cnt += (c > 0u) ? 1u : 0u; mine = (j == x) ? c : mine; }
        if (sum == G) break;
        __builtin_amdgcn_s_sleep(1);
        if ((++sp & 255u) == 0u) { if (xb_ld(&bar[XB_TMO])) break; if (sp > XB_SPIN_CAP) { atomicAdd(&bar[XB_TMO], 1u); break; } }
    }
    nloc = mine > 0u ? mine : 1u; nx = cnt > 0u ? cnt : 1u;
}

__device__ __forceinline__ void xcd_barrier(const XcdBarrier& b) {
    asm volatile("s_waitcnt vmcnt(0)" ::: "memory");
    __syncthreads();
    if (threadIdx.x == 0) {
        unsigned* bar = b.bar;
        __builtin_amdgcn_s_waitcnt(0);
        unsigned nloc = b.st[0], nx = b.st[1];
        if (nloc == 0u) { xcd_barrier_complete(bar, b.x, nloc, nx); b.st[0] = nloc; b.st[1] = nx; }
        const unsigned old = xb_add(&bar[XB_XSUB(b.x)], 1u);
        const unsigned gen = old / nloc;
        if (old + 1u == (gen + 1u) * nloc) {
            __builtin_amdgcn_fence(__ATOMIC_RELEASE, "agent");
            asm volatile("s_waitcnt vmcnt(0)" ::: "memory");
            const unsigned og = xb_add(&bar[XB_TOP], 1u);
            const unsigned tg = og / nx;
            if (og + 1u == (tg + 1u) * nx) xb_add(&bar[XB_TOPGEN], 1u);
            else XB_SPIN(xb_ld(&bar[XB_TOPGEN]) == tg, bar);
            __builtin_amdgcn_fence(__ATOMIC_ACQUIRE, "agent");
            xb_add(&bar[XB_XGEN(b.x)], 1u);
            asm volatile("s_waitcnt vmcnt(0)" ::: "memory");
        } else {
            XB_SPIN(xb_ld(&bar[XB_XGEN(b.x)]) == gen, bar);
            __builtin_amdgcn_fence(__ATOMIC_ACQUIRE, "agent");
            asm volatile("s_waitcnt vmcnt(0)" ::: "memory");
        }
    }
    __syncthreads();
}

constexpr int XB_ST_OFF = LDS_BYTES - 64;
static_assert(CK_END <= XB_ST_OFF && pg8::STAGE_BYTES <= XB_ST_OFF, "barrier LDS words clear of the phase scratch");
__global__ void __launch_bounds__(NTHR, 2) fwd_megakernel(Args a) {
    extern __shared__ __attribute__((aligned(16))) unsigned char lds_g[];
    cg::grid_group grid = cg::this_grid();
#define PHASE_IDS() int tid = threadIdx.x; asm volatile("" : "+v"(tid)); const int lane = tid & 63, wave = __builtin_amdgcn_readfirstlane(tid >> 6); const int G = gridDim.x, gw = blockIdx.x * NWAVES + wave, NGW = G * NWAVES; (void)lane; (void)gw; (void)NGW; (void)G
#define WSP(T, off) ((T*)(KWS() + (off)))
#define LDS_P ((PG8_LAS unsigned char*)lds_g)
    if (threadIdx.x == 0) { ((volatile LAS unsigned*)((LAS unsigned char*)lds_g + XB_ST_OFF))[0] = 0u; ((volatile LAS unsigned*)((LAS unsigned char*)lds_g + XB_ST_OFF))[1] = 0u; }
    __syncthreads();
    (void)xcd_barrier_post((unsigned*)KWS(), (volatile LAS unsigned*)((LAS unsigned char*)lds_g + XB_ST_OFF));
#define GSYNC() do { XcdBarrier b_; b_.bar = (unsigned*)KWS(); b_.x = xb_xcc_id(); b_.st = (volatile LAS unsigned*)((LAS unsigned char*)lds_g + XB_ST_OFF); xcd_barrier(b_); } while (0)
    { PHASE_IDS(); p0_mod(a, lds_g, tid, wave, lane); p0_weights(a, lds_g, gw, NGW, wave, lane); }
    grid.sync();
    { PHASE_IDS(); const float* MOD = WSP(const float, WS_MOD); row_pass<false, true, false, 0>(KIN(I_X), nullptr, WSP(bf16, WS_H), nullptr, nullptr, MOD + 0, MOD + 1024, gw, NGW, lane); }
    GSYNC();

    for (int l = 0; l < DEPTH; ++l) {
        { pg8::Gemm g{WSP(const bf16, WS_H), WSP(const bf16, WS_W + (size_t)l * W_LAYER + WO_IN), M, NIN, D}; pg8::StaticOrder S; S.init(M, NIN, (int)gridDim.x, (int)blockIdx.x); pg8::EpiBf16 E{WSP(bf16, WS_P), NIN};
          pg8::gemm_phase<pg8::EpiBf16, pg8::StaticOrder, true, true>(LDS_P, g, S, E); }
        GSYNC();
        { PHASE_IDS(); p2a_conv_act(WSP(const bf16, WS_P), ((bf16*)KOUT()), WSP(bf16, WS_ACT), KIN(I_CONVW) + (size_t)l * 3 * 512, KIN(I_MU) + (size_t)l * 1792, gw, NGW, lane); }
        GSYNC();
        { pg8::Gemm g{WSP(const bf16, WS_ACT), WSP(const bf16, WS_W + (size_t)l * W_LAYER + WO_LORA), M, NLN, NLK}; pg8::StaticOrder S; S.init(M, NLN, (int)gridDim.x, (int)blockIdx.x); pg8::EpiBf16 E{WSP(bf16, WS_LORA), NLN};
          pg8::gemm_phase<pg8::EpiBf16, pg8::StaticOrder, true, true>(LDS_P, g, S, E); }
        GSYNC();
        { PHASE_IDS(); p3_chunked<1>(l, lds_g, WSP(const bf16, WS_P), WSP(const bf16, WS_LORA), ((bf16*)KOUT()), WSP(float, WS_ACT), tid, wave, lane); }
        GSYNC();
        { PHASE_IDS(); p3_chunked<2>(l, lds_g, WSP(const bf16, WS_P), WSP(const bf16, WS_LORA), ((bf16*)KOUT()), WSP(float, WS_ACT), tid, wave, lane); }
        GSYNC();
        { pg8::Gemm g{((const bf16*)KOUT()), WSP(const bf16, WS_W + (size_t)l * W_LAYER + WO_OUT), M, D, D}; pg8::StaticOrder S; S.init(M, D, (int)gridDim.x, (int)blockIdx.x);
          if (l == 0) { pg8::EpiRes<true> E{KIN(I_X), WSP(bf16, WS_XZ), WSP(const float, WS_MOD) + (size_t)l * BATCH * NMOD + 2048, ALPHA};
              pg8::gemm_phase<pg8::EpiRes<true>, pg8::StaticOrder, true, true>(LDS_P, g, S, E); }
          else { pg8::EpiRes<false> E{WSP(const bf16, WS_XZ), WSP(bf16, WS_XZ), WSP(const float, WS_MOD) + (size_t)l * BATCH * NMOD + 2048, ALPHA};
              pg8::gemm_phase<pg8::EpiRes<false>, pg8::StaticOrder, true, true>(LDS_P, g, S, E); } }
        GSYNC();
        { PHASE_IDS(); const float* modl = WSP(const float, WS_MOD) + (size_t)l * BATCH * NMOD;
          row_pass<true, true, true, 1>(WSP(const bf16, WS_XZ), WSP(bf16, WS_XZ), WSP(bf16, WS_H), KIN(I_LN1G) + (size_t)l * D, KIN(I_LN1B) + (size_t)l * D, modl + 3072, modl + 4096, gw, NGW, lane); }
        GSYNC();
        { pg8::Gemm g{WSP(const bf16, WS_H), WSP(const bf16, WS_W + (size_t)l * W_LAYER + WO_FI), M, 2 * DFF, D}; pg8::StaticOrder S; S.init(M, 2 * DFF, (int)gridDim.x, (int)blockIdx.x); pg8::EpiSwiGLU E{WSP(bf16, WS_P), DFF};
          pg8::gemm_phase<pg8::EpiSwiGLU, pg8::StaticOrder, true, true>(LDS_P, g, S, E); }
        GSYNC();
        { pg8::Gemm g{WSP(const bf16, WS_P), WSP(const bf16, WS_W + (size_t)l * W_LAYER + WO_FO), M, D, DFF}; pg8::StaticOrder S; S.init(M, D, (int)gridDim.x, (int)blockIdx.x);
          pg8::EpiRes<false> E{WSP(const bf16, WS_XZ), WSP(bf16, WS_XZ), WSP(const float, WS_MOD) + (size_t)l * BATCH * NMOD + 5120, ALPHA};
          pg8::gemm_phase<pg8::EpiRes<false>, pg8::StaticOrder, true, true>(LDS_P, g, S, E); }
        GSYNC();
        { PHASE_IDS();
          if (l + 1 < DEPTH) { const float* modn = WSP(const float, WS_MOD) + (size_t)(l + 1) * BATCH * NMOD;
              row_pass<true, true, true, 1>(WSP(const bf16, WS_XZ), WSP(bf16, WS_XZ), WSP(bf16, WS_H), KIN(I_LN2G) + (size_t)l * D, KIN(I_LN2B) + (size_t)l * D, modn + 0, modn + 1024, gw, NGW, lane); }
          else row_pass<true, false, true, 2>(WSP(const bf16, WS_XZ), KOUT(), nullptr, KIN(I_LN2G) + (size_t)l * D, KIN(I_LN2B) + (size_t)l * D, nullptr, nullptr, gw, NGW, lane); }
        if (l + 1 < DEPTH) GSYNC();
    }
}

extern "C" void kernel_launch(void* const* d_in, const int* in_sizes, int n_in, void* d_out, int out_size, void* d_ws, size_t ws_size, hipStream_t stream) {
    static int grid = 0;
    if (grid == 0) {
        if (n_in != 24 || out_size != M * D || ws_size < WS_END) { fprintf(stderr, "kernel_launch: unexpected problem (n_in %d out %d ws %zu)\n", n_in, out_size, ws_size); grid = -1; return; }
        int dev = 0, cus = 0, per_cu = 0;
        hipGetDevice(&dev); hipDeviceGetAttribute(&cus, hipDeviceAttributeMultiprocessorCount, dev);
        if (hipFuncSetAttribute((const void*)fwd_megakernel, hipFuncAttributeMaxDynamicSharedMemorySize, LDS_BYTES) != hipSuccess) { fprintf(stderr, "kernel_launch: hipFuncSetAttribute failed\n"); grid = -1; return; }
        if (hipOccupancyMaxActiveBlocksPerMultiprocessor(&per_cu, (const void*)fwd_megakernel, NTHR, LDS_BYTES) != hipSuccess || per_cu < 1) { fprintf(stderr, "kernel_launch: occupancy query says %d\n", per_cu); per_cu = 1; }
        (void)hipGetLastError();
        grid = cus;
        fprintf(stderr, "kernel_launch: grid %d (cus %d, per_cu %d)\n", grid, cus, per_cu);
    }
    if (grid < 0) return;
    if (hipMemsetAsync(d_ws, 0, 65536, stream) != hipSuccess) { fprintf(stderr, "kernel_launch: memset of the barrier words failed\n"); return; }
    Args a{};
    for (int i = 0; i < 24; ++i) a.in[i] = (const float*)d_in[i];
    a.out = (float*)d_out; a.ws = (unsigned char*)d_ws;
    void* args[] = {&a};
    hipError_t e = hipLaunchCooperativeKernel((const void*)fwd_megakernel, dim3(grid), dim3(NTHR), args, LDS_BYTES, stream);
    if (e != hipSuccess) fprintf(stderr, "kernel_launch: cooperative launch failed: %s\n", hipGetErrorString(e));
}
```

```cpp
#include <hip/hip_runtime.h>
#include <hip/hip_cooperative_groups.h>
#include <cstdio>
#include <cstdint>
namespace cg = cooperative_groups;
typedef _Float16 hf2_t __attribute__((ext_vector_type(2)));
typedef float ff2_t __attribute__((ext_vector_type(2)));
__device__ __forceinline__ unsigned pkh2(float lo, float hi) { ff2_t v = {lo, hi}; hf2_t h = __builtin_convertvector(v, hf2_t); return __builtin_bit_cast(unsigned, h); }
__device__ __forceinline__ ff2_t uph2(unsigned w) { hf2_t h = __builtin_bit_cast(hf2_t, w); return __builtin_convertvector(h, ff2_t); }
namespace pg8 {
#define PG8_LAS __attribute__((address_space(3)))
typedef unsigned short bf16_t;
typedef short bf16x8 __attribute__((ext_vector_type(8)));
typedef float f32x4 __attribute__((ext_vector_type(4)));
typedef unsigned u32x4 __attribute__((ext_vector_type(4)));
constexpr int BM = 256, BK = 64, HALF = 128, HTB = HALF * BK * 2  , STAGE_BYTES = 8 * HTB, NXCD = 8, WGM = 8;

__host__ __device__ __forceinline__ int lds_byte(int r, int c) { const int st = (r >> 4) * 2 + (c >> 5), rr = r & 15, cc = c & 31, ob = rr * 64 + cc * 2; return st * 1024 + (ob ^ (((ob >> 9) & 1) << 5)); }
__host__ __device__ __forceinline__ void stage_rc(int b, int& R, int& C) { const int st = b / 1024, sb = b % 1024, swz = sb ^ (((sb >> 9) & 1) << 5); R = (st >> 1) * 16 + swz / 64; C = (st & 1) * 32 + (swz % 64) / 2; }
__host__ __device__ __forceinline__ int perm32(int rho) { const int n = rho >> 4, i = rho & 15; return 8 * (i >> 2) + 4 * n + (i & 3); }

struct Unit { int pm, pn; };
struct Gemm { const bf16_t* A; const bf16_t* Bt; int M, N, K; };

struct StaticOrder {
    int nM, nN, nwg, G, c;
    __host__ __device__ void init(int M, int N, int G_, int c_) { nM = M / BM; nN = N / BM; nwg = nM * nN; G = G_; c = c_; }
    __host__ __device__ bool next(int i, Unit& u) const {
        const long L = (long)i * G + c; if (L >= nwg) return false;
        int wgid = (int)L; { const int q = nwg / NXCD, r = nwg % NXCD, xcd = wgid % NXCD, off = wgid / NXCD; wgid = (xcd < r ? xcd * (q + 1) : r * (q + 1) + (xcd - r) * q) + off; }
        const int nig = WGM * nN, gid = wgid / nig, fm = gid * WGM, gsz = (nM - fm) < WGM ? (nM - fm) : WGM;
        u.pm = fm + ((wgid % nig) % gsz); u.pn = (wgid % nig) / gsz; return true;
    }
    __device__ __forceinline__ void a_ready(const Unit&) const {}
    __device__ __forceinline__ void done(const Unit&) const {}
};

__device__ __forceinline__ unsigned cvt_pk_bf16(float lo, float hi) { unsigned r; asm volatile("v_cvt_pk_bf16_f32 %0, %1, %2" : "=v"(r) : "v"(lo), "v"(hi)); return r; }
struct EpiBf16 {
    static constexpr bool PERM = true, AFTER_DRAIN = false;
    bf16_t* O; int ldc;
    __device__ __forceinline__ void operator()(const f32x4 (&acc)[2][2][4][2], const Unit& u, int wr, int wc, int fr, int fq) const {
        const int row0 = u.pm * BM + wr * 64 + fr; const int col0 = u.pn * BM + wc * 32 + 8 * fq;
#pragma unroll
        for (int ai = 0; ai < 2; ++ai)
#pragma unroll
            for (int m = 0; m < 4; ++m) { bf16_t* rowp = O + (size_t)(row0 + ai * HALF + m * 16) * ldc + col0;
#pragma unroll
                for (int bj = 0; bj < 2; ++bj) { const f32x4 v0 = acc[ai][bj][m][0], v1 = acc[ai][bj][m][1];
                    u32x4 w; w.x = cvt_pk_bf16(v0[0], v0[1]); w.y = cvt_pk_bf16(v0[2], v0[3]); w.z = cvt_pk_bf16(v1[0], v1[1]); w.w = cvt_pk_bf16(v1[2], v1[3]);
                    *(u32x4*)(rowp + bj * HALF) = w; } }
    }
};
template <bool XF32> struct EpiRes {
    static constexpr bool PERM = true, AFTER_DRAIN = false;
    const void* xsrc; bf16_t* zdst; const float* gt; float alpha;
    __device__ __forceinline__ void operator()(const f32x4 (&acc)[2][2][4][2], const Unit& u, int wr, int wc, int fr, int fq) const {
        const int row0 = u.pm * BM + wr * 64 + fr; const int col0 = u.pn * BM + wc * 32 + 8 * fq;
        const float* gtb = gt + (size_t)(u.pm >> 5) * 6144 + col0;
        f32x4 g[2][2];
#pragma unroll
        for (int bj = 0; bj < 2; ++bj)
#pragma unroll
            for (int n = 0; n < 2; ++n) g[bj][n] = *(const f32x4*)(gtb + bj * HALF + 4 * n) + 1.0f;
#pragma unroll
        for (int ai = 0; ai < 2; ++ai)
#pragma unroll
            for (int m = 0; m < 4; ++m) { const size_t ro = (size_t)(row0 + ai * HALF + m * 16) * 1024 + col0;
#pragma unroll
                for (int bj = 0; bj < 2; ++bj) { const size_t o = ro + bj * HALF;
                    f32x4 x0, x1;
                    if (XF32) { x0 = *(const f32x4*)((const float*)xsrc + o); x1 = *(const f32x4*)((const float*)xsrc + o + 4); }
                    else { const u32x4 xw = *(const u32x4*)((const bf16_t*)xsrc + o); const ff2_t a0 = uph2(xw.x), a1 = uph2(xw.y), a2 = uph2(xw.z), a3 = uph2(xw.w);
                        x0 = (f32x4){a0.x, a0.y, a1.x, a1.y}; x1 = (f32x4){a2.x, a2.y, a3.x, a3.y}; }
                    const f32x4 z0 = x0 * alpha + g[bj][0] * acc[ai][bj][m][0], z1 = x1 * alpha + g[bj][1] * acc[ai][bj][m][1];
                    u32x4 w; w.x = pkh2(z0[0], z0[1]); w.y = pkh2(z0[2], z0[3]); w.z = pkh2(z1[0], z1[1]); w.w = pkh2(z1[2], z1[3]);
                    *(u32x4*)(zdst + o) = w; } }
    }
};
struct EpiSwiGLU {
    static constexpr bool PERM = true, AFTER_DRAIN = false;
    bf16_t* O; int ldc;
    __device__ __forceinline__ void operator()(const f32x4 (&acc)[2][2][4][2], const Unit& u, int wr, int wc, int fr, int fq) const {
        const int row0 = u.pm * BM + wr * 64 + fr; const int col0 = u.pn * HALF + wc * 32 + 8 * fq;
#pragma unroll
        for (int ai = 0; ai < 2; ++ai)
#pragma unroll
            for (int m = 0; m < 4; ++m) { bf16_t* rowp = O + (size_t)(row0 + ai * HALF + m * 16) * ldc + col0;
                float r[8];
#pragma unroll
                for (int n = 0; n < 2; ++n)
#pragma unroll
                    for (int i = 0; i < 4; ++i) { const float gv = acc[ai][0][m][n][i], uv = acc[ai][1][m][n][i];
                        r[4 * n + i] = gv * __builtin_amdgcn_rcpf(1.0f + __expf(-gv)) * uv; }
                u32x4 w; w.x = cvt_pk_bf16(r[0], r[1]); w.y = cvt_pk_bf16(r[2], r[3]); w.z = cvt_pk_bf16(r[4], r[5]); w.w = cvt_pk_bf16(r[6], r[7]);
                *(u32x4*)rowp = w; }
    }
};

template <class Epi, class Sched, bool ALIGN_EPI = false, bool SP2 = false>
__device__ __forceinline__ void gemm_phase(PG8_LAS unsigned char* lds, const Gemm g, const Sched& S, const Epi& E) {
    int tid_ = threadIdx.x; asm volatile("" : "+v"(tid_));
    const int tid = tid_, wid = __builtin_amdgcn_readfirstlane(tid >> 6), lane = tid & 63, wr = wid >> 2, wc = wid & 3, fr = lane & 15, fq = lane >> 4;
    int K_ = g.K; asm volatile("" : "+s"(K_));
    const int K = K_, nt = K / BK;
    unsigned voffA[2], voffB[2];
#pragma unroll
    for (int i = 0; i < 2; ++i) { int R, C; stage_rc(tid * 16 + i * 8192, R, C); const int Rb = Epi::PERM ? ((R & ~31) + perm32(R & 31)) : R;
        voffA[i] = (unsigned)(R * K + C) * 2u; voffB[i] = (unsigned)(Rb * K + C) * 2u; }
    const size_t kstep = (size_t)(BK * 2);
    const size_t hstep = (size_t)HALF * K * 2;
    const size_t tstep = 2 * hstep;
    const unsigned ldsw = (unsigned)wid * 1024u;
    const int aoff = lds_byte(wr * 64 + fr, fq * 8), boff = lds_byte(wc * 32 + fr, fq * 8);
#define PG8_SA(b, h) (((b) * 2 + (h)) * HTB)
#define PG8_SB(b, h) ((4 + (b) * 2 + (h)) * HTB)
#define PG8_STAGE(bufoff, gbase, voff) do { _Pragma("unroll") for (int _i = 0; _i < 2; ++_i) \
        __builtin_amdgcn_global_load_lds((const unsigned*)((const char*)(gbase) + (voff)[_i]), (PG8_LAS unsigned*)(lds + (bufoff) + ldsw + _i * 8192), 16, 0, 0); } while (0)
#define PG8_LDA(dst, b, h) do { _Pragma("unroll") for (int m = 0; m < 4; ++m) _Pragma("unroll") for (int k = 0; k < 2; ++k) dst[m][k] = *(const PG8_LAS bf16x8*)(lds + PG8_SA(b, h) + aoff + m * 2048 + k * 1024); } while (0)
#define PG8_LDB(dst, b, h) do { _Pragma("unroll") for (int n = 0; n < 2; ++n) _Pragma("unroll") for (int k = 0; k < 2; ++k) dst[n][k] = *(const PG8_LAS bf16x8*)(lds + PG8_SB(b, h) + boff + n * 2048 + k * 1024); } while (0)
#define PG8_MMA(ai, bj, At, Bt) do { __builtin_amdgcn_s_setprio(1); _Pragma("unroll") for (int m = 0; m < 4; ++m) _Pragma("unroll") for (int n = 0; n < 2; ++n) _Pragma("unroll") for (int k = 0; k < 2; ++k) \
        acc[ai][bj][m][n] = __builtin_amdgcn_mfma_f32_16x16x32_bf16(Bt[n][k], At[m][k], acc[ai][bj][m][n], 0, 0, 0); __builtin_amdgcn_s_setprio(0); } while (0)
#define PG8_WAIT_V(n) asm volatile("s_waitcnt vmcnt(" #n ")" ::: "memory")
#define PG8_WAIT_L(n) asm volatile("s_waitcnt lgkmcnt(" #n ")" ::: "memory")
#define PG8_BAR __builtin_amdgcn_s_barrier()
#define PG8_SCHED __builtin_amdgcn_sched_barrier(0)
    Unit cur, nxt; int ui = 0;
    if (!S.next(0, cur)) return;
    f32x4 acc[2][2][4][2];
#pragma unroll
    for (int a = 0; a < 2; ++a)
#pragma unroll
        for (int b = 0; b < 2; ++b)
#pragma unroll
            for (int m = 0; m < 4; ++m)
#pragma unroll
                for (int n = 0; n < 2; ++n) acc[a][b][m][n] = (f32x4){0.f, 0.f, 0.f, 0.f};
    bf16x8 At[4][2], B0[2][2], B1[2][2];
    const char* cA = (const char*)g.A + (size_t)cur.pm * tstep; const char* cB = (const char*)g.Bt + (size_t)cur.pn * tstep;
    S.a_ready(cur);
    if constexpr (SP2) {
        PG8_STAGE(PG8_SB(0, 0), cB, voffB); PG8_STAGE(PG8_SB(0, 1), cB + hstep, voffB); PG8_STAGE(PG8_SA(0, 0), cA, voffA); PG8_STAGE(PG8_SA(0, 1), cA + hstep, voffA);
        if (wr == 1) PG8_BAR;
        PG8_WAIT_V(2); PG8_BAR;
        PG8_STAGE(PG8_SB(1, 0), cB + kstep, voffB); PG8_STAGE(PG8_SA(1, 0), cA + kstep, voffA); PG8_STAGE(PG8_SB(1, 1), cB + hstep + kstep, voffB);
        PG8_WAIT_V(6); PG8_BAR;
    } else {
        PG8_STAGE(PG8_SB(0, 0), cB, voffB); PG8_STAGE(PG8_SA(0, 0), cA, voffA); PG8_STAGE(PG8_SB(0, 1), cB + hstep, voffB); PG8_STAGE(PG8_SA(0, 1), cA + hstep, voffA);
        if (wr == 1) PG8_BAR;
        PG8_WAIT_V(4); PG8_BAR;
        PG8_STAGE(PG8_SB(1, 0), cB + kstep, voffB); PG8_STAGE(PG8_SA(1, 0), cA + kstep, voffA); PG8_STAGE(PG8_SB(1, 1), cB + hstep + kstep, voffB);
        PG8_WAIT_V(6); PG8_BAR;
    }
    for (;;) {
        const bool has_next = S.next(ui + 1, nxt);
        const char* nA = has_next ? (const char*)g.A + (size_t)nxt.pm * tstep : cA; const char* nB = has_next ? (const char*)g.Bt + (size_t)nxt.pn * tstep : cB;
        for (int t = 0; t < nt; t += 2) {
            const bool last = (t == nt - 2);
            const char* a1 = cA + (size_t)(t + 1) * kstep;
            const char* a2 = last ? nA : cA + (size_t)(t + 2) * kstep; const char* b2 = last ? nB : cB + (size_t)(t + 2) * kstep;
            const char* a3 = a2 + kstep; const char* b3 = b2 + kstep;
            if (last && has_next) S.a_ready(nxt);
            if constexpr (SP2) {
            PG8_LDB(B0, 0, 0); PG8_LDB(B1, 0, 1); PG8_SCHED; PG8_LDA(At, 0, 0); PG8_STAGE(PG8_SA(1, 1), a1 + hstep, voffA);
            PG8_WAIT_V(8); PG8_WAIT_L(0); PG8_BAR; PG8_MMA(0, 0, At, B0); PG8_MMA(0, 1, At, B1); PG8_BAR; PG8_SCHED;
            PG8_LDA(At, 0, 1); PG8_STAGE(PG8_SB(0, 0), b2, voffB); PG8_STAGE(PG8_SB(0, 1), b2 + hstep, voffB); PG8_STAGE(PG8_SA(0, 0), a2, voffA);
            PG8_WAIT_V(8); PG8_WAIT_L(0); PG8_BAR; PG8_MMA(1, 0, At, B0); PG8_MMA(1, 1, At, B1); PG8_BAR; PG8_SCHED;
            PG8_LDB(B0, 1, 0); PG8_LDB(B1, 1, 1); PG8_SCHED; PG8_LDA(At, 1, 0); PG8_STAGE(PG8_SA(0, 1), a2 + hstep, voffA);
            PG8_WAIT_V(8); PG8_WAIT_L(0); PG8_BAR; PG8_MMA(0, 0, At, B0); PG8_MMA(0, 1, At, B1); PG8_BAR; PG8_SCHED;
            PG8_LDA(At, 1, 1); PG8_STAGE(PG8_SB(1, 0), b3, voffB); PG8_STAGE(PG8_SB(1, 1), b3 + hstep, voffB); PG8_STAGE(PG8_SA(1, 0), a3, voffA);
            PG8_WAIT_V(8); PG8_WAIT_L(0); PG8_BAR; PG8_MMA(1, 0, At, B0); PG8_MMA(1, 1, At, B1); PG8_BAR; PG8_SCHED;
            } else {
            PG8_LDB(B0, 0, 0); PG8_SCHED; PG8_LDA(At, 0, 0); PG8_STAGE(PG8_SA(1, 1), a1 + hstep, voffA);
            PG8_WAIT_L(8); PG8_BAR; PG8_WAIT_L(0); PG8_MMA(0, 0, At, B0); PG8_BAR; PG8_SCHED;
            PG8_LDB(B1, 0, 1); PG8_STAGE(PG8_SB(0, 0), b2, voffB);
            PG8_BAR; PG8_WAIT_L(0); PG8_MMA(0, 1, At, B1); PG8_BAR;
            PG8_LDA(At, 0, 1); PG8_STAGE(PG8_SA(0, 0), a2, voffA);
            PG8_BAR; PG8_WAIT_L(0); PG8_MMA(1, 0, At, B0); PG8_BAR; PG8_SCHED;
            PG8_STAGE(PG8_SB(0, 1), b2 + hstep, voffB);
            PG8_WAIT_V(6); PG8_BAR; PG8_MMA(1, 1, At, B1); PG8_BAR;
            PG8_LDB(B0, 1, 0); PG8_SCHED; PG8_LDA(At, 1, 0); PG8_STAGE(PG8_SA(0, 1), a2 + hstep, voffA);
            PG8_WAIT_L(8); PG8_BAR; PG8_WAIT_L(0); PG8_MMA(0, 0, At, B0); PG8_BAR; PG8_SCHED;
            PG8_LDB(B1, 1, 1); PG8_STAGE(PG8_SB(1, 0), b3, voffB);
            PG8_BAR; PG8_WAIT_L(0); PG8_MMA(0, 1, At, B1); PG8_BAR;
            PG8_LDA(At, 1, 1); PG8_STAGE(PG8_SA(1, 0), a3, voffA);
            PG8_BAR; PG8_WAIT_L(0); PG8_MMA(1, 0, At, B0); PG8_BAR; PG8_SCHED;
            PG8_STAGE(PG8_SB(1, 1), b3 + hstep, voffB);
            PG8_WAIT_V(6); PG8_BAR; PG8_MMA(1, 1, At, B1); PG8_BAR;
            }
        }
        if constexpr (ALIGN_EPI) { if (wr == 0) PG8_BAR; }
        if constexpr (!Epi::AFTER_DRAIN) { E(acc, cur, wr, wc, fr, fq); S.done(cur); }
        if (!has_next) break;
#pragma unroll
        for (int a = 0; a < 2; ++a)
#pragma unroll
            for (int b = 0; b < 2; ++b)
#pragma unroll
                for (int m = 0; m < 4; ++m)
#pragma unroll
                    for (int n = 0; n < 2; ++n) acc[a][b][m][n] = (f32x4){0.f, 0.f, 0.f, 0.f};
        cur = nxt; cA = nA; cB = nB; ++ui;
        if constexpr (ALIGN_EPI) { if (wr == 1) PG8_BAR; }
    }
    PG8_WAIT_V(0);
    if constexpr (!ALIGN_EPI) { if (wr == 0) PG8_BAR; }
    PG8_BAR;
    if constexpr (Epi::AFTER_DRAIN) { E.fused(acc, cur, wr, wc, fr, fq, lds, wid, lane); S.done(cur); }
#undef PG8_SA
#undef PG8_SB
#undef PG8_STAGE
#undef PG8_LDA
#undef PG8_LDB
#undef PG8_MMA
#undef PG8_WAIT_V
#undef PG8_WAIT_L
#undef PG8_BAR
#undef PG8_SCHED
}
}
constexpr int BATCH = 4, SEQ = 8192, D = 1024, DEPTH = 4, M = BATCH * SEQ;
constexpr int HS = 64, NH = 8, DFF = 2816, NIN = 3328, SHIFT0 = 1536, NLK = 256, NLN = 1536, NMOD = 6144;
constexpr float ALPHA = 1.681792830507429f;
constexpr float LN_EPS = 1e-5f, GN_EPS = 64e-5f;
constexpr int NWAVES = 8, NTHR = 512, LDS_BYTES = 147456;
constexpr size_t MiB = 1u << 20;
constexpr size_t WS_MOD = 1 * MiB;
constexpr size_t WS_W = 2 * MiB, W_LAYER = 25 * MiB + 768 * 1024;
constexpr size_t WO_IN = 0, WO_LORA = 6 * MiB + 512 * 1024, WO_OUT = WO_LORA + 768 * 1024, WO_FI = WO_OUT + 2 * MiB, WO_FO = WO_FI + 11 * MiB;
constexpr size_t WS_H = 106 * MiB;
constexpr size_t WS_LORA = 106 * MiB;
constexpr size_t WS_XZ = 202 * MiB;
constexpr size_t WS_P = 266 * MiB;
constexpr size_t WS_ACT = 474 * MiB;
constexpr size_t WS_END = 490 * MiB;
static_assert(WO_FO + (size_t)D * DFF * 2 == W_LAYER && WS_W + DEPTH * W_LAYER <= WS_H && WS_LORA + (size_t)M * NLN * 2 <= WS_XZ && WS_P + (size_t)M * NIN * 2 <= WS_ACT, "ws map");

typedef unsigned short bf16;
typedef float f32x4 __attribute__((ext_vector_type(4)));
typedef unsigned u32x4 __attribute__((ext_vector_type(4)));
typedef unsigned u32x2 __attribute__((ext_vector_type(2)));
#define LAS __attribute__((address_space(3)))
__device__ __forceinline__ unsigned f2bf(float f) { unsigned u = __builtin_bit_cast(unsigned, f); return (u + 0x7fffu + ((u >> 16) & 1u)) >> 16; }
__device__ __forceinline__ unsigned pk2(float lo, float hi) { return f2bf(lo) | (f2bf(hi) << 16); }
__device__ __forceinline__ float bf2f(unsigned short v) { return __builtin_bit_cast(float, (unsigned)v << 16); }
__device__ __forceinline__ float bflo(unsigned w) { return __builtin_bit_cast(float, w << 16); }
__device__ __forceinline__ float bfhi(unsigned w) { return __builtin_bit_cast(float, w & 0xffff0000u); }
__device__ __forceinline__ float sigmoidf_(float x) { return __builtin_amdgcn_rcpf(1.0f + __expf(-x)); }
__device__ __forceinline__ float wave_sum(float v) {
#pragma unroll
    for (int o = 1; o < 64; o <<= 1) v += __shfl_xor(v, o);
    return v;
}
template <int CTRL> __device__ __forceinline__ float dpp_f(float v) { return __builtin_bit_cast(float, __builtin_amdgcn_update_dpp(0, __builtin_bit_cast(int, v), CTRL, 0xf, 0xf, true)); }
__device__ __forceinline__ float sum8(float v) { v += dpp_f<0xB1>(v); v += dpp_f<0x4E>(v); v += dpp_f<0x141>(v); return v; }

struct Args { const float* in[24]; float* out; unsigned char* ws; };
__device__ __forceinline__ const float* karg_in(int i) {
    const unsigned char __attribute__((address_space(4)))* kp = (const unsigned char __attribute__((address_space(4)))*)__builtin_amdgcn_kernarg_segment_ptr();
    asm volatile("" : "+s"(kp));
    return *(const float* const __attribute__((address_space(4)))*)(kp + 8 * i);
}
__device__ __forceinline__ unsigned char* karg_ptr(int i) { return (unsigned char*)karg_in(i); }
#define KIN(i) karg_in(i)
#define KOUT() ((float*)karg_ptr(24))
#define KWS() (karg_ptr(25))
enum { I_X = 0, I_C, I_WMOD, I_BMOD, I_WIN, I_CONVW, I_MU, I_W0, I_WDU, I_A0, I_AUP, I_GUP, I_KK, I_KA, I_RK, I_LNXG, I_LNXB, I_WOUT, I_LN1G, I_LN1B, I_WFI, I_WFO, I_LN2G, I_LN2B };

__device__ __forceinline__ void transpose_item(const float* W, int K, int N, bf16* WT, int mode, float* scr, int item, int lane) {
    const int nblk = N / 32, kb = item / nblk, nb = item % nblk, k0 = 64 * kb, n0 = 32 * nb;
#pragma unroll 8
    for (int i = 0; i < 32; ++i) { const int kk = 2 * i + (lane >> 5); scr[kk * 33 + (lane & 31)] = W[(size_t)(k0 + kk) * N + n0 + (lane & 31)]; }
    asm volatile("s_waitcnt lgkmcnt(0)" ::: "memory");
    int d0 = n0;
    if (mode == 1) { const int bj = n0 / DFF, rem = n0 % DFF; d0 = 256 * (rem / 128) + 128 * bj + (rem % 128); }
    const int c = lane & 7;
#pragma unroll
    for (int j = 0; j < 4; ++j) { const int n = (lane >> 3) + 8 * j; const float* s = scr + (8 * c) * 33 + n;
        u32x4 o; o.x = pk2(s[0 * 33], s[1 * 33]); o.y = pk2(s[2 * 33], s[3 * 33]); o.z = pk2(s[4 * 33], s[5 * 33]); o.w = pk2(s[6 * 33], s[7 * 33]);
        *(u32x4*)(WT + (size_t)(d0 + n) * K + k0 + 8 * c) = o; }
    asm volatile("s_waitcnt lgkmcnt(0)" ::: "memory");
}

__device__ __forceinline__ void p0_weights(const Args& a, unsigned char* lds_g, int gw, int NGW, int wave, int lane) {
    float* scr = (float*)(lds_g + 32768 + wave * 8704);
    constexpr int I_IN = 16 * 104, I_OUT = 16 * 32, I_FI = 16 * 176, I_FO = 44 * 32, I_L = I_IN + I_OUT + I_FI + I_FO;
    for (int it = gw; it < DEPTH * I_L; it += NGW) {
        const int l = it / I_L; int r = it % I_L; unsigned char* wl = KWS() + WS_W + (size_t)l * W_LAYER;
        if (r < I_IN) { transpose_item(KIN(I_WIN) + (size_t)l * D * NIN, D, NIN, (bf16*)(wl + WO_IN), 0, scr, r, lane); continue; } r -= I_IN;
        if (r < I_OUT) { transpose_item(KIN(I_WOUT) + (size_t)l * D * D, D, D, (bf16*)(wl + WO_OUT), 0, scr, r, lane); continue; } r -= I_OUT;
        if (r < I_FI) { transpose_item(KIN(I_WFI) + (size_t)l * D * 2 * DFF, D, 2 * DFF, (bf16*)(wl + WO_FI), 1, scr, r, lane); continue; } r -= I_FI;
        transpose_item(KIN(I_WFO) + (size_t)l * DFF * D, DFF, D, (bf16*)(wl + WO_FO), 0, scr, r, lane);
    }
    const int gt = gw * 64 + lane, NGT = NGW * 64;
    for (int ch = gt; ch < DEPTH * NLN * 32; ch += NGT) {
        const int l = ch / (NLN * 32), rr = ch % (NLN * 32), n = rr / 32, k0 = 8 * (rr % 32), seg = n / 512, nn = n % 512;
        const float* src = nullptr;
        if (seg == 0 && k0 < 64) src = KIN(I_WDU) + (size_t)l * 64 * 512 + (size_t)k0 * 512 + nn;
        else if (seg == 1 && k0 >= 64 && k0 < 128) src = KIN(I_AUP) + (size_t)l * 64 * 512 + (size_t)(k0 - 64) * 512 + nn;
        else if (seg == 2 && k0 >= 128) src = KIN(I_GUP) + (size_t)l * 128 * 512 + (size_t)(k0 - 128) * 512 + nn;
        u32x4 o = (u32x4){0u, 0u, 0u, 0u};
        if (src) { o.x = pk2(src[0], src[512]); o.y = pk2(src[1024], src[1536]); o.z = pk2(src[2048], src[2560]); o.w = pk2(src[3072], src[3584]); }
        *(u32x4*)((bf16*)(KWS() + WS_W + (size_t)l * W_LAYER + WO_LORA) + (size_t)n * NLK + k0) = o;
    }
}
__device__ __forceinline__ void p0_mod(const Args& a, unsigned char* lds_g, int tid, int wave, int lane) {
    float* sc = (float*)lds_g;
    float* red = sc + 4096;
    const float* c = KIN(I_C);
    for (int i = tid; i < BATCH * D; i += NTHR) { const float v = c[i]; sc[i] = v / (1.0f + __expf(-v)); }
    __syncthreads();
    float* MOD = (float*)(KWS() + WS_MOD);
    const int cl = lane & 31, hf = lane >> 5;
    for (int item = blockIdx.x; item < DEPTH * 192; item += gridDim.x) {
        const int l = item / 192, jc = item % 192, i0 = wave * 128 + hf * 64;
        const float* wp = KIN(I_WMOD) + ((size_t)l * D + i0) * NMOD + jc * 32 + cl;
        float a0 = 0.f, a1 = 0.f, a2 = 0.f, a3 = 0.f;
#pragma unroll 16
        for (int i = 0; i < 64; ++i) { const float w = wp[(size_t)i * NMOD]; const int ii = i0 + i;
            a0 += sc[ii] * w; a1 += sc[1024 + ii] * w; a2 += sc[2048 + ii] * w; a3 += sc[3072 + ii] * w; }
        const int pr = wave * 2 + hf;
        red[(pr * 4 + 0) * 32 + cl] = a0; red[(pr * 4 + 1) * 32 + cl] = a1; red[(pr * 4 + 2) * 32 + cl] = a2; red[(pr * 4 + 3) * 32 + cl] = a3;
        __syncthreads();
        if (tid < 128) { const int bb = tid >> 5, ln = tid & 31; float s = 0.f;
#pragma unroll
            for (int w = 0; w < 16; ++w) s += red[(w * 4 + bb) * 32 + ln];
            MOD[(size_t)(l * BATCH + bb) * NMOD + jc * 32 + ln] = s + KIN(I_BMOD)[(size_t)l * NMOD + jc * 32 + ln]; }
        __syncthreads();
    }
}
typedef float f32x2_t __attribute__((ext_vector_type(2)));
typedef __bf16 bf16x2_t __attribute__((ext_vector_type(2)));
__device__ __forceinline__ unsigned cvtpk(float lo, float hi) { f32x2_t v = {lo, hi}; bf16x2_t b = __builtin_convertvector(v, bf16x2_t); return __builtin_bit_cast(unsigned, b); }
template <int CTRL, int RMASK> __device__ __forceinline__ float dpp_m(float v) { return __builtin_bit_cast(float, __builtin_amdgcn_update_dpp(0, __builtin_bit_cast(int, v), CTRL, RMASK, 0xf, true)); }
__device__ __forceinline__ float wave_total(float v) {
    v += dpp_m<0x111, 0xf>(v); v += dpp_m<0x112, 0xf>(v); v += dpp_m<0x114, 0xf>(v); v += dpp_m<0x118, 0xf>(v);
    v += dpp_m<0x142, 0xa>(v);
    v += dpp_m<0x143, 0xc>(v);
    return __builtin_bit_cast(float, __builtin_amdgcn_readlane(__builtin_bit_cast(int, v), 63));
}
template <bool LN, bool WRITE_H, bool IN16, int XOUT> __device__ __forceinline__ void row_pass(const void* xin, void* xout, bf16* H, const float* lg, const float* lb, const float* modsh, const float* modsc, int gw, int NGW, int lane) {
    f32x4 nx[4]; u32x2 nw[4];
#define RP_LOAD(row) do { if (IN16) { const u32x2* xr_ = (const u32x2*)((const bf16*)xin + (size_t)(row) * D) + lane; _Pragma("unroll") for (int j_ = 0; j_ < 4; ++j_) nw[j_] = xr_[64 * j_]; } \
        else { const f32x4* xr_ = (const f32x4*)((const float*)xin + (size_t)(row) * D) + lane; _Pragma("unroll") for (int j_ = 0; j_ < 4; ++j_) nx[j_] = xr_[64 * j_]; } } while (0)
    if (gw < M) RP_LOAD(gw);
    for (int m = gw; m < M; m += NGW) {
        f32x4 v[4];
#pragma unroll
        for (int j = 0; j < 4; ++j) { if (IN16) { const ff2_t a0 = uph2(nw[j].x), a1 = uph2(nw[j].y); v[j] = (f32x4){a0.x, a0.y, a1.x, a1.y}; } else v[j] = nx[j]; }
        if (m + NGW < M) RP_LOAD(m + NGW);
        if (LN) {
            float s = 0.f;
#pragma unroll
            for (int j = 0; j < 4; ++j) s += (v[j].x + v[j].y) + (v[j].z + v[j].w);
            const float mean = wave_total(s) * (1.f / D); float s2 = 0.f;
#pragma unroll
            for (int j = 0; j < 4; ++j) { v[j] = v[j] - mean; s2 += (v[j].x * v[j].x + v[j].y * v[j].y) + (v[j].z * v[j].z + v[j].w * v[j].w); }
            const float rstd = 1.f / sqrtf(wave_total(s2) * (1.f / D) + LN_EPS);
#pragma unroll
            for (int j = 0; j < 4; ++j) { const f32x4 g = ((const f32x4*)lg)[lane + 64 * j], bb = ((const f32x4*)lb)[lane + 64 * j]; v[j] = v[j] * rstd * g + bb;
                if (XOUT == 2) ((f32x4*)((float*)xout + (size_t)m * D) + lane)[64 * j] = v[j];
                if (XOUT == 1) { u32x2 o; o.x = pkh2(v[j].x, v[j].y); o.y = pkh2(v[j].z, v[j].w); ((u32x2*)((bf16*)xout + (size_t)m * D) + lane)[64 * j] = o; } }
        }
        if (WRITE_H) {
            const int b = m / SEQ;
            const f32x4* sh = (const f32x4*)(modsh + (size_t)b * NMOD) + lane; const f32x4* sc = (const f32x4*)(modsc + (size_t)b * NMOD) + lane;
            u32x2* ho = (u32x2*)(H + (size_t)m * D) + lane;
#pragma unroll
            for (int j = 0; j < 4; ++j) { const f32x4 h = v[j] * (sc[64 * j] + 1.0f) + sh[64 * j]; u32x2 o; o.x = cvtpk(h.x, h.y); o.y = cvtpk(h.z, h.w); ho[64 * j] = o; }
        }
    }
#undef RP_LOAD
}
__device__ __forceinline__ void p2a_conv_act(const bf16* P, bf16* MIX, bf16* ACT, const float* convw, const float* mu, int gw, int NGW, int lane) {
    float cw[3][8];
#pragma unroll
    for (int k = 0; k < 3; ++k)
#pragma unroll
        for (int i = 0; i < 8; ++i) cw[k][i] = convw[k * 512 + lane * 8 + i];
    float mul[4];
#pragma unroll
    for (int i = 0; i < 4; ++i) mul[i] = mu[1536 + lane * 4 + i];
    for (int run = gw; run < M / 16; run += NGW) {
        const int m0 = run * 16, t0 = m0 % SEQ;
        float z1[8], z2[8], pl[4];
#pragma unroll
        for (int i = 0; i < 8; ++i) { z1[i] = 0.f; z2[i] = 0.f; }
#pragma unroll
        for (int i = 0; i < 4; ++i) pl[i] = 0.f;
        if (t0 > 0) {
            const bf16* p1 = P + (size_t)(m0 - 1) * NIN; const bf16* p2 = P + (size_t)(m0 - 2) * NIN;
            const u32x4 c1 = *(const u32x4*)(p1 + 512 + lane * 8), u1 = *(const u32x4*)(p1 + 1024 + lane * 8);
            const u32x4 c2 = *(const u32x4*)(p2 + 512 + lane * 8), u2 = *(const u32x4*)(p2 + 1024 + lane * 8);
#pragma unroll
            for (int q = 0; q < 4; ++q) { z1[2 * q] = bflo(c1[q]) * bflo(u1[q]); z1[2 * q + 1] = bfhi(c1[q]) * bfhi(u1[q]); z2[2 * q] = bflo(c2[q]) * bflo(u2[q]); z2[2 * q + 1] = bfhi(c2[q]) * bfhi(u2[q]); }
            const u32x2 l1 = *(const u32x2*)(p1 + 3072 + lane * 4);
            pl[0] = bflo(l1.x); pl[1] = bfhi(l1.x); pl[2] = bflo(l1.y); pl[3] = bfhi(l1.y);
        }
        u32x4 nbb, ncc, nuu; u32x2 nll;
        { const bf16* p0 = P + (size_t)m0 * NIN; nbb = *(const u32x4*)(p0 + lane * 8); ncc = *(const u32x4*)(p0 + 512 + lane * 8); nuu = *(const u32x4*)(p0 + 1024 + lane * 8); nll = *(const u32x2*)(p0 + 3072 + lane * 4); }
#pragma unroll 2
        for (int tt = 0; tt < 16; ++tt) {
            const u32x4 bb = nbb, cc = ncc, uu = nuu; const u32x2 ll = nll;
            if (tt + 1 < 16) { const bf16* p0 = P + (size_t)(m0 + tt + 1) * NIN;
                nbb = *(const u32x4*)(p0 + lane * 8); ncc = *(const u32x4*)(p0 + 512 + lane * 8); nuu = *(const u32x4*)(p0 + 1024 + lane * 8); nll = *(const u32x2*)(p0 + 3072 + lane * 4); }
            float z0[8], bg[8], y[8];
#pragma unroll
            for (int q = 0; q < 4; ++q) { z0[2 * q] = bflo(cc[q]) * bflo(uu[q]); z0[2 * q + 1] = bfhi(cc[q]) * bfhi(uu[q]); bg[2 * q] = bflo(bb[q]); bg[2 * q + 1] = bfhi(bb[q]); }
#pragma unroll
            for (int i = 0; i < 8; ++i) { y[i] = bg[i] * (cw[0][i] * z2[i] + cw[1][i] * z1[i] + cw[2][i] * z0[i]); z2[i] = z1[i]; z1[i] = z0[i]; }
            u32x4 o; o.x = pk2(y[0], y[1]); o.y = pk2(y[2], y[3]); o.z = pk2(y[4], y[5]); o.w = pk2(y[6], y[7]);
            *(u32x4*)(MIX + (size_t)(m0 + tt) * D + lane * 8) = o;
            float cur[4] = {bflo(ll.x), bfhi(ll.x), bflo(ll.y), bfhi(ll.y)}, av[4];
#pragma unroll
            for (int i = 0; i < 4; ++i) { const float xs = cur[i] + mul[i] * (pl[i] - cur[i]); pl[i] = cur[i];
                av[i] = (lane < 16) ? tanhf(xs) : ((lane < 32) ? xs : sigmoidf_(xs)); }
            u32x2 oa; oa.x = pk2(av[0], av[1]); oa.y = pk2(av[2], av[3]);
            *(u32x2*)(ACT + (size_t)(m0 + tt) * NLK + lane * 4) = oa;
        }
    }
}
typedef short s4v __attribute__((ext_vector_type(4)));
typedef LAS unsigned short LB;
constexpr int LDT = 24, LDJ = 72;
constexpr int SZ_J = 16 * LDJ * 2, SZ_C = 64 * LDT * 2, SZ_S = 16 * LDT * 2;
constexpr int SL_AT = 0, SL_QE = SL_AT + SZ_J, SL_BPT = SL_QE + SZ_J, SL_KET = SL_BPT + SZ_C, SL_VT = SL_KET + SZ_C, SL_WV = SL_VT + SZ_C, SL_PC = SL_WV + SZ_S, SL_BON = SL_PC + 256, SLOT_BYTES = SL_BON + 64;
constexpr int SC_BT = 0, SC_KT = SC_BT + SZ_J, SC_RT = SC_KT + SZ_J, SC_ATT = SC_RT + SZ_J, SC_BTT = SC_ATT + SZ_C, SC_NP = SC_BTT + SZ_C, SC_NPT = SC_NP + SZ_S, SC_TM = SC_NPT + SZ_S, SC_TT = SC_TM + SZ_S,
              SC_NAKT = SC_TT + SZ_S, SC_MRB = SC_NAKT + SZ_S, SC_X = SC_MRB + SZ_S, SCR_BYTES = SC_X + SZ_S;
constexpr int CK_SLOTS = 0, CK_SCR = 4 * SLOT_BYTES, CK_YBUF = CK_SCR + 4 * SCR_BYTES, CK_END = CK_YBUF + 64 * 64 * 2;
static_assert(SLOT_BYTES % 16 == 0 && SCR_BYTES % 16 == 0 && CK_END <= LDS_BYTES, "chunked-scan LDS map");
__device__ __forceinline__ f32x4 mm16(const LB* A, int lda, const LB* BT, int ldb, f32x4 acc, int c, int q) {
    const s4v a = *(const LAS s4v*)(A + c * lda + 4 * q);
    const s4v b = *(const LAS s4v*)(BT + c * ldb + 4 * q);
    return __builtin_amdgcn_mfma_f32_16x16x16bf16_1k(a, b, acc, 0, 0, 0);
}
__device__ __forceinline__ f32x4 mm64(const LB* A, const LB* BT, int c, int q) {
    f32x4 acc = {0.f, 0.f, 0.f, 0.f};
#pragma unroll
    for (int ks = 0; ks < 4; ++ks) acc = mm16(A + 16 * ks, LDJ, BT + 16 * ks, LDJ, acc, c, q);
    return acc;
}
__device__ __forceinline__ void stT(LB* O, int ldo, f32x4 v, int c, int q) { u32x2 w; w.x = cvtpk(v[0], v[1]); w.y = cvtpk(v[2], v[3]); *(LAS u32x2*)(O + c * ldo + 4 * q) = w; }
__device__ __forceinline__ void stN(LB* O, int ldo, f32x4 v, int c, int q) {
#pragma unroll
    for (int r = 0; r < 4; r += 2) { const unsigned w = cvtpk(v[r], v[r + 1]); O[(4 * q + r) * ldo + c] = (unsigned short)w; O[(4 * q + r + 1) * ldo + c] = (unsigned short)(w >> 16); }
}
__device__ __forceinline__ s4v bf4(f32x4 v) { u32x2 w; w.x = cvtpk(v[0], v[1]); w.y = cvtpk(v[2], v[3]); return __builtin_bit_cast(s4v, w); }

constexpr int NSEG = 8, SEG_SS = SEQ / 64 / NSEG;
template <int PASS> __device__ __forceinline__ void p3_chunked(int l, unsigned char* lds_g, const bf16* P, const bf16* LORA, bf16* MIX, float* SEG, int tid, int wave, int lane) {
    if (blockIdx.x >= BATCH * NH * NSEG) return;
    const int bh = blockIdx.x & 31, seg = blockIdx.x >> 5, b = bh >> 3, h = bh & 7;
    LAS unsigned char* lds = (LAS unsigned char*)lds_g;
    const int c = lane & 15, q = lane >> 4;
    const int hc = h * 64 + lane;
    const float* mu = KIN(I_MU) + (size_t)l * 1792;
    const float mu_r = mu[hc], mu_k = mu[512 + hc], mu_v = mu[1024 + hc];
    const float w0c = KIN(I_W0)[l * 512 + hc], a0c = KIN(I_A0)[l * 512 + hc], kkc = KIN(I_KK)[l * 512 + hc], kac = KIN(I_KA)[l * 512 + hc], rkc = KIN(I_RK)[l * 512 + hc];
    const float lgc = KIN(I_LNXG)[l * 512 + hc], lbc = KIN(I_LNXB)[l * 512 + hc];
    f32x4 Sreg[4], Greg[4];
#pragma unroll
    for (int T = 0; T < 4; ++T) { Sreg[T] = (f32x4){0.f, 0.f, 0.f, 0.f};
#pragma unroll
        for (int r = 0; r < 4; ++r) Greg[T][r] = (PASS == 1 && 16 * T + 4 * q + r == 16 * (wave & 3) + c) ? 1.0f : 0.0f; }
    if (PASS == 2 && wave < 4) {
        for (int s = 0; s < seg; ++s) {
            const float* Gt = SEG + ((size_t)(bh * NSEG + s) * 2 + 0) * 4096; const float* Ht = SEG + ((size_t)(bh * NSEG + s) * 2 + 1) * 4096;
            s4v sb[4];
#pragma unroll
            for (int T = 0; T < 4; ++T) sb[T] = bf4(Sreg[T]);
#pragma unroll
            for (int T2 = 0; T2 < 4; ++T2) {
                f32x4 acc;
#pragma unroll
                for (int r = 0; r < 4; ++r) acc[r] = Ht[(16 * T2 + 4 * q + r) * 64 + 16 * wave + c];
#pragma unroll
                for (int T = 0; T < 4; ++T) { const f32x4 gv = *(const f32x4*)(Gt + (16 * T2 + c) * 64 + 16 * T + 4 * q);
                    acc = __builtin_amdgcn_mfma_f32_16x16x16bf16_1k(bf4(gv), sb[T], acc, 0, 0, 0); }
                Sreg[T2] = acc;
            }
        }
    }
    const bf16* Pb = P + (size_t)b * SEQ * NIN + SHIFT0 + hc;
    const bf16* Lb = LORA + (size_t)b * SEQ * NLN + hc;
    const int pw = wave & 3, half = wave >> 2;
    unsigned short raw[8][5], rawp[3], rawlw[8], graw[8];
#define LOAD_RAW(ssn) do { const int tok0_ = 16 * (4 * (ssn) + pw) + 8 * half; \
        if (tok0_ > 0) { const bf16* pp_ = Pb + (size_t)(tok0_ - 1) * NIN; rawp[0] = pp_[0]; rawp[1] = pp_[512]; rawp[2] = pp_[1024]; } else { rawp[0] = 0; rawp[1] = 0; rawp[2] = 0; } \
        _Pragma("unroll") for (int t_ = 0; t_ < 8; ++t_) { const bf16* pc_ = Pb + (size_t)(tok0_ + t_) * NIN; const bf16* lc_ = Lb + (size_t)(tok0_ + t_) * NLN; \
            raw[t_][0] = pc_[0]; raw[t_][1] = pc_[512]; raw[t_][2] = pc_[1024]; raw[t_][3] = lc_[0]; raw[t_][4] = lc_[512]; \
            rawlw[t_] = half ? Lb[(size_t)(tok0_ - 8 + t_) * NLN] : (unsigned short)0; \
            if (PASS == 2) graw[t_] = Lb[((size_t)(ssn) * 64 + wave * 8 + t_) * NLN + 1024]; } } while (0)
    LOAD_RAW(seg * SEG_SS);
    for (int ss = seg * SEG_SS; ss < (seg + 1) * SEG_SS; ++ss) {
        unsigned short gcur[8];
#pragma unroll
        for (int i_ = 0; i_ < 8; ++i_) gcur[i_] = graw[i_];
        {
            LB* SL = (LB*)(lds + CK_SLOTS + pw * SLOT_BYTES); LB* SC = (LB*)(lds + CK_SCR + pw * SCR_BYTES);
            LB* sAt = SL + SL_AT / 2; LB* sVT = SL + SL_VT / 2; LAS float* sPC = (LAS float*)(SL + SL_PC / 2); LAS float* sBon = (LAS float*)(SL + SL_BON / 2);
            LB* cBt = SC + SC_BT / 2; LB* cKt = SC + SC_KT / 2; LB* cRt = SC + SC_RT / 2; LB* cATT = SC + SC_ATT / 2; LB* cBTT = SC + SC_BTT / 2;
            float pr = bf2f(rawp[0]), pk = bf2f(rawp[1]), pv = bf2f(rawp[2]), cs = 0.f;
            if (half) {
#pragma unroll
                for (int t = 0; t < 8; ++t) cs += 0.6065306597126334f * sigmoidf_(w0c + bf2f(rawlw[t]));
            }
            float ptp = __expf(-cs);
            unsigned pkA[4], pkB[4], pkV[4]; float loA = 0.f, loB = 0.f, loV = 0.f;
#pragma unroll
            for (int t8 = 0; t8 < 8; ++t8) {
                const int t = 8 * half + t8;
                const float cr = bf2f(raw[t8][0]), ck = bf2f(raw[t8][1]), cv = bf2f(raw[t8][2]), lw = bf2f(raw[t8][3]), la = bf2f(raw[t8][4]);
                const float r = cr + mu_r * (pr - cr), k = ck + mu_k * (pk - ck), v = cv + mu_v * (pv - cv);
                pr = cr; pk = ck; pv = cv;
                const float e = 0.6065306597126334f * sigmoidf_(w0c + lw);
                const float lr = sigmoidf_(a0c + la);
                const float kkv = k * kkc; const float n2 = wave_total(kkv * kkv);
                const float kk = kkv * __builtin_amdgcn_rsqf(fmaxf(n2, 1e-24f));
                const float k2 = k * (1.0f + (lr - 1.0f) * kac);
                float bon = 0.f; if (PASS == 2) bon = wave_total(r * k2 * rkc);
                const float pm1 = ptp; cs += e; const float pt = __expf(-cs), ipt = __builtin_amdgcn_rcpf(pt); ptp = pt;
                const float At_ = -kk * pm1, Bt_ = kk * lr * ipt, Kt_ = k2 * ipt, Rt_ = r * pt;
                { const unsigned ab = cvtpk(At_, Bt_), kr = cvtpk(Kt_, Rt_); sAt[t * LDJ + lane] = (unsigned short)ab; cBt[t * LDJ + lane] = (unsigned short)(ab >> 16); cKt[t * LDJ + lane] = (unsigned short)kr; cRt[t * LDJ + lane] = (unsigned short)(kr >> 16); }
                if (PASS == 2 && lane == 0) sBon[t] = bon;
                if (t8 & 1) { pkA[t8 >> 1] = cvtpk(loA, At_); pkB[t8 >> 1] = cvtpk(loB, Bt_); pkV[t8 >> 1] = cvtpk(loV, v); } else { loA = At_; loB = Bt_; loV = v; }
            }
            if (half) sPC[lane] = ptp;
            *(LAS u32x4*)(cATT + lane * LDT + 8 * half) = (u32x4){pkA[0], pkA[1], pkA[2], pkA[3]};
            *(LAS u32x4*)(cBTT + lane * LDT + 8 * half) = (u32x4){pkB[0], pkB[1], pkB[2], pkB[3]};
            *(LAS u32x4*)(sVT + lane * LDT + 8 * half) = (u32x4){pkV[0], pkV[1], pkV[2], pkV[3]};
            if (ss + 1 < (seg + 1) * SEG_SS) LOAD_RAW(ss + 1);
        }
        __syncthreads();
        if (wave < 4) {
            LB* SL = (LB*)(lds + CK_SLOTS + wave * SLOT_BYTES); LB* SC = (LB*)(lds + CK_SCR + wave * SCR_BYTES);
            LB* sAt = SL + SL_AT / 2; LB* sQe = SL + SL_QE / 2; LB* sBpT = SL + SL_BPT / 2; LB* sKeT = SL + SL_KET / 2; LB* sWv = SL + SL_WV / 2;
            LB* cBt = SC + SC_BT / 2; LB* cKt = SC + SC_KT / 2; LB* cRt = SC + SC_RT / 2; LB* cATT = SC + SC_ATT / 2; LB* cBTT = SC + SC_BTT / 2;
            LB* cNp = SC + SC_NP / 2; LB* cNpT = SC + SC_NPT / 2; LB* cTm = SC + SC_TM / 2; LB* cTT = SC + SC_TT / 2; LB* cNakT = SC + SC_NAKT / 2; LB* cMrb = SC + SC_MRB / 2; LB* cX = SC + SC_X / 2;
            f32x4 Nab = mm64(sAt, cBt, c, q), Nak = mm64(sAt, cKt, c, q), Mrb = mm64(cRt, cBt, c, q), Mrk = mm64(cRt, cKt, c, q);
#pragma unroll
            for (int r = 0; r < 4; ++r) { const int t = 4 * q + r; if (!(t > c)) { Nab[r] = 0.f; Nak[r] = 0.f; } if (!(t >= c)) { Mrb[r] = 0.f; Mrk[r] = 0.f; } }
            stN(cNp, LDT, Nab, c, q); stT(cNpT, LDT, Nab, c, q); stT(cNakT, LDT, Nak, c, q); stN(cMrb, LDT, Mrb, c, q);
            f32x4 Tr = Nab;
#pragma unroll
            for (int r = 0; r < 4; ++r) if (4 * q + r == c) Tr[r] += 1.0f;
#pragma unroll
            for (int it = 0; it < 3; ++it) {
                stN(cTm, LDT, Tr, c, q);
                const f32x4 N2 = mm16(cNp, LDT, cNpT, LDT, (f32x4){0.f, 0.f, 0.f, 0.f}, c, q);
                stN(cNp, LDT, N2, c, q); stT(cNpT, LDT, N2, c, q);
                Tr = mm16(cTm, LDT, cNpT, LDT, Tr, c, q);
            }
            stT(cTT, LDT, Tr, c, q);
            const f32x4 Xr = mm16(cMrb, LDT, cTT, LDT, (f32x4){0.f, 0.f, 0.f, 0.f}, c, q);
            stN(cX, LDT, Xr, c, q);
            if (PASS == 2) { const f32x4 Wv = mm16(cX, LDT, cNakT, LDT, Mrk, c, q); stN(sWv, LDT, Wv, c, q); }
#pragma unroll
            for (int jt = 0; jt < 4; ++jt) {
                f32x4 a0;
#pragma unroll
                for (int r = 0; r < 4; ++r) a0[r] = bf2f(cRt[(4 * q + r) * LDJ + 16 * jt + c]);
                if (PASS == 2) { const f32x4 Qe = mm16(cX, LDT, cATT + 16 * jt * LDT, LDT, a0, c, q);
                    stN(sQe + 16 * jt, LDJ, Qe, c, q); }
                const f32x4 Bp = mm16(cTT, LDT, cBTT + 16 * jt * LDT, LDT, (f32x4){0.f, 0.f, 0.f, 0.f}, c, q);
                stT(sBpT + 16 * jt * LDT, LDT, Bp, c, q);
                f32x4 k0;
#pragma unroll
                for (int r = 0; r < 4; ++r) k0[r] = bf2f(cKt[(4 * q + r) * LDJ + 16 * jt + c]);
                const f32x4 Ke = mm16(cNakT, LDT, sBpT + 16 * jt * LDT, LDT, k0, c, q);
                stT(sKeT + 16 * jt * LDT, LDT, Ke, c, q);
            }
        }
        __syncthreads();
        if (wave < 4) {
            LB* ybuf = (LB*)(lds + CK_YBUF);
#pragma unroll 1
            for (int cl = 0; cl < 4; ++cl) {
                LB* SL = (LB*)(lds + CK_SLOTS + cl * SLOT_BYTES);
                LB* sAt = SL + SL_AT / 2; LB* sQe = SL + SL_QE / 2; LB* sBpT = SL + SL_BPT / 2; LB* sKeT = SL + SL_KET / 2; LB* sVT = SL + SL_VT / 2; LB* sWv = SL + SL_WV / 2;
                LAS float* sPC = (LAS float*)(SL + SL_PC / 2);
                s4v sb[4], gb[4];
#pragma unroll
                for (int T = 0; T < 4; ++T) { sb[T] = bf4(Sreg[T]); gb[T] = bf4(Greg[T]); }
                const s4v vb = *(const LAS s4v*)(sVT + (16 * wave + c) * LDT + 4 * q);
                f32x4 X = {0.f, 0.f, 0.f, 0.f}, Y = {0.f, 0.f, 0.f, 0.f}, XG = {0.f, 0.f, 0.f, 0.f};
#pragma unroll
                for (int T = 0; T < 4; ++T) {
                    const s4v at = *(const LAS s4v*)(sAt + c * LDJ + 16 * T + 4 * q);
                    X = __builtin_amdgcn_mfma_f32_16x16x16bf16_1k(at, sb[T], X, 0, 0, 0);
                    if (PASS == 1) XG = __builtin_amdgcn_mfma_f32_16x16x16bf16_1k(at, gb[T], XG, 0, 0, 0);
                    if (PASS == 2) Y = __builtin_amdgcn_mfma_f32_16x16x16bf16_1k(*(const LAS s4v*)(sQe + c * LDJ + 16 * T + 4 * q), sb[T], Y, 0, 0, 0);
                }
                if (PASS == 2) Y = __builtin_amdgcn_mfma_f32_16x16x16bf16_1k(*(const LAS s4v*)(sWv + c * LDT + 4 * q), vb, Y, 0, 0, 0);
                const s4v xb = bf4(X), xgb = bf4(XG);
#pragma unroll
                for (int T = 0; T < 4; ++T) {
                    f32x4 s = Sreg[T];
                    const s4v bp = *(const LAS s4v*)(sBpT + (16 * T + c) * LDT + 4 * q);
                    s = __builtin_amdgcn_mfma_f32_16x16x16bf16_1k(bp, xb, s, 0, 0, 0);
                    s = __builtin_amdgcn_mfma_f32_16x16x16bf16_1k(*(const LAS s4v*)(sKeT + (16 * T + c) * LDT + 4 * q), vb, s, 0, 0, 0);
                    const f32x4 pc = *(const LAS f32x4*)(sPC + 16 * T + 4 * q);
                    Sreg[T] = s * pc;
                    if (PASS == 1) Greg[T] = __builtin_amdgcn_mfma_f32_16x16x16bf16_1k(bp, xgb, Greg[T], 0, 0, 0) * pc;
                }
                if (PASS == 2) {
#pragma unroll
                    for (int r = 0; r < 4; r += 2) { const unsigned w = cvtpk(Y[r], Y[r + 1]); ybuf[(cl * 16 + 4 * q + r) * 64 + 16 * wave + c] = (unsigned short)w; ybuf[(cl * 16 + 4 * q + r + 1) * 64 + 16 * wave + c] = (unsigned short)(w >> 16); }
                }
            }
        }
        __syncthreads();
        if (PASS == 2) {
            const LB* ybuf = (const LB*)(lds + CK_YBUF);
#pragma unroll
            for (int i = 0; i < 8; ++i) {
                const int tt = wave * 8 + i, cl = tt >> 4, t = tt & 15; const size_t tok = (size_t)ss * 64 + tt;
                const LB* SL = (const LB*)(lds + CK_SLOTS + cl * SLOT_BYTES);
                const float g = bf2f(gcur[i]);
                const float y = bf2f(ybuf[tt * 64 + lane]), v = bf2f(SL[SL_VT / 2 + lane * LDT + t]), bon = ((const LAS float*)(SL + SL_BON / 2))[t];
                const float mean = wave_total(y) * (1.f / 64.f); const float d = y - mean; const float var = wave_total(d * d) * (1.f / 64.f);
                const float yn = d * __builtin_amdgcn_rsqf(var + GN_EPS) * lgc + lbc;
                MIX[((size_t)b * SEQ + tok) * D + 512 + hc] = (bf16)f2bf((yn + bon * v) * g);
            }
        }
        if (PASS == 2) __syncthreads();
    }
    if (PASS == 1 && wave < 4) {
        float* Gt = SEG + ((size_t)(bh * NSEG + seg) * 2 + 0) * 4096; float* Ht = SEG + ((size_t)(bh * NSEG + seg) * 2 + 1) * 4096;
#pragma unroll
        for (int T = 0; T < 4; ++T)
#pragma unroll
            for (int r = 0; r < 4; ++r) { Gt[(16 * T + 4 * q + r) * 64 + 16 * wave + c] = Greg[T][r]; Ht[(16 * T + 4 * q + r) * 64 + 16 * wave + c] = Sreg[T][r]; }
    }
#undef LOAD_RAW
}

#define XB_TMO      128
#define XB_XCNT(j)  (256  + 64 * (j))
#define XB_XSUB(j)  (1280 + 64 * (j))
#define XB_XGEN(j)  (2304 + 64 * (j))
#define XB_TOP      3328
#define XB_TOPGEN   3392
#define XCD_BAR_WORDS 3456
#define XB_SPIN_CAP (1u << 18)

__device__ __forceinline__ unsigned xb_ld(unsigned* p)              { return __hip_atomic_load(p, __ATOMIC_RELAXED, __HIP_MEMORY_SCOPE_AGENT); }
__device__ __forceinline__ unsigned xb_add(unsigned* p, unsigned v) { return __hip_atomic_fetch_add(p, v, __ATOMIC_RELAXED, __HIP_MEMORY_SCOPE_AGENT); }
__device__ __forceinline__ unsigned xb_xcc_id() { return (unsigned)__builtin_amdgcn_s_getreg((3 << 11) | 20) & 0xFu; }
#define XB_SPIN(cond, bar) do { unsigned _sp = 0; while (cond) { __builtin_amdgcn_s_sleep(1); \
    if ((++_sp & 255u) == 0u) { if (xb_ld(&(bar)[XB_TMO])) break; if (_sp > XB_SPIN_CAP) { atomicAdd(&(bar)[XB_TMO], 1u); break; } } } } while (0)

struct XcdBarrier {
    unsigned* bar; unsigned x;
    volatile LAS unsigned* st;
};

__device__ __forceinline__ XcdBarrier xcd_barrier_post(unsigned* bar, volatile LAS unsigned* st) {
    XcdBarrier b; b.bar = bar; b.x = xb_xcc_id(); b.st = st;
    if (threadIdx.x == 0) (void)xb_add(&bar[XB_XCNT(b.x)], 1u);
    return b;
}
__device__ __forceinline__ void xcd_barrier_complete(unsigned* bar, unsigned x, unsigned& nloc, unsigned& nx) {
    const unsigned G = gridDim.x * gridDim.y * gridDim.z;
    unsigned sum, cnt, mine, sp = 0u;
    for (;;) {
        sum = 0u; cnt = 0u; mine = 0u;
#pragma unroll
        for (unsigned j = 0; j < 16; ++j) { const unsigned c = xb_ld(&bar[XB_XCNT(j)]); sum += c; cnt += (c > 0u) ? 1u : 0u; mine = (j == x) ? c : mine; }
        if (sum == G) break;
        __builtin_amdgcn_s_sleep(1);
        if ((++sp & 255u) == 0u) { if (xb_ld(&bar[XB_TMO])) break; if (sp > XB_SPIN_CAP) { atomicAdd(&bar[XB_TMO], 1u); break; } }
    }
    nloc = mine > 0u ? mine : 1u; nx = cnt > 0u ? cnt : 1u;
}

__device__ __forceinline__ void xcd_barrier(const XcdBarrier& b) {
    asm volatile("s_waitcnt vmcnt(0)" ::: "memory");
    __syncthreads();
    if (threadIdx.x == 0) {
        unsigned* bar = b.bar;
        __builtin_amdgcn_s_waitcnt(0);
        unsigned nloc = b.st[0], nx = b.st[1];
        if (nloc == 0u) { xcd_barrier_complete(bar, b.x, nloc, nx); b.st[0] = nloc; b.st[1] = nx; }
        const unsigned old = xb_add(&bar[XB_XSUB(b.x)], 1u);
        const unsigned gen = old / nloc;
        if (old + 1u == (gen + 1u) * nloc) {
            __builtin_amdgcn_fence(__ATOMIC_RELEASE, "agent");
            asm volatile("s_waitcnt vmcnt(0)" ::: "memory");
            const unsigned og = xb_add(&bar[XB_TOP], 1u);
            const unsigned tg = og / nx;
            if (og + 1u == (tg + 1u) * nx) xb_add(&bar[XB_TOPGEN], 1u);
            else XB_SPIN(xb_ld(&bar[XB_TOPGEN]) == tg, bar);
            __builtin_amdgcn_fence(__ATOMIC_ACQUIRE, "agent");
            xb_add(&bar[XB_XGEN(b.x)], 1u);
            asm volatile("s_waitcnt vmcnt(0)" ::: "memory");
        } else {
            XB_SPIN(xb_ld(&bar[XB_XGEN(b.x)]) == gen, bar);
            __builtin_amdgcn_fence(__ATOMIC_ACQUIRE, "agent");
            asm volatile("s_waitcnt vmcnt(0)" ::: "memory");
        }
    }
    __syncthreads();
}

constexpr int XB_ST_OFF = LDS_BYTES - 64;
static_assert(CK_END <= XB_ST_OFF && pg8::STAGE_BYTES <= XB_ST_OFF, "barrier LDS words clear of the phase scratch");
__global__ void __launch_bounds__(NTHR, 2) fwd_megakernel(Args a) {
    extern __shared__ __attribute__((aligned(16))) unsigned char lds_g[];
    cg::grid_group grid = cg::this_grid();
#define PHASE_IDS() int tid = threadIdx.x; asm volatile("" : "+v"(tid)); const int lane = tid & 63, wave = __builtin_amdgcn_readfirstlane(tid >> 6); const int G = gridDim.x, gw = blockIdx.x * NWAVES + wave, NGW = G * NWAVES; (void)lane; (void)gw; (void)NGW; (void)G
#define WSP(T, off) ((T*)(KWS() + (off)))
#define LDS_P ((PG8_LAS unsigned char*)lds_g)
    if (threadIdx.x == 0) { ((volatile LAS unsigned*)((LAS unsigned char*)lds_g + XB_ST_OFF))[0] = 0u; ((volatile LAS unsigned*)((LAS unsigned char*)lds_g + XB_ST_OFF))[1] = 0u; }
    __syncthreads();
    (void)xcd_barrier_post((unsigned*)KWS(), (volatile LAS unsigned*)((LAS unsigned char*)lds_g + XB_ST_OFF));
#define GSYNC() do { XcdBarrier b_; b_.bar = (unsigned*)KWS(); b_.x = xb_xcc_id(); b_.st = (volatile LAS unsigned*)((LAS unsigned char*)lds_g + XB_ST_OFF); xcd_barrier(b_); } while (0)
    { PHASE_IDS(); p0_mod(a, lds_g, tid, wave, lane); }
    if (gridDim.x > 0x7fffffffu) grid.sync();
    GSYNC();
    { PHASE_IDS(); const float* MOD = WSP(const float, WS_MOD); row_pass<false, true, false, 0>(KIN(I_X), nullptr, WSP(bf16, WS_H), nullptr, nullptr, MOD + 0, MOD + 1024, gw, NGW, lane);
      p0_weights(a, lds_g, gw, NGW, wave, lane); }
    GSYNC();

    for (int l = 0; l < DEPTH; ++l) {
        { pg8::Gemm g{WSP(const bf16, WS_H), WSP(const bf16, WS_W + (size_t)l * W_LAYER + WO_IN), M, NIN, D}; pg8::StaticOrder S; S.init(M, NIN, (int)gridDim.x, (int)blockIdx.x); pg8::EpiBf16 E{WSP(bf16, WS_P), NIN};
          pg8::gemm_phase<pg8::EpiBf16, pg8::StaticOrder, true, true>(LDS_P, g, S, E); }
        GSYNC();
        { PHASE_IDS(); p2a_conv_act(WSP(const bf16, WS_P), ((bf16*)KOUT()), WSP(bf16, WS_ACT), KIN(I_CONVW) + (size_t)l * 3 * 512, KIN(I_MU) + (size_t)l * 1792, gw, NGW, lane); }
        GSYNC();
        { pg8::Gemm g{WSP(const bf16, WS_ACT), WSP(const bf16, WS_W + (size_t)l * W_LAYER + WO_LORA), M, NLN, NLK}; pg8::StaticOrder S; S.init(M, NLN, (int)gridDim.x, (int)blockIdx.x); pg8::EpiBf16 E{WSP(bf16, WS_LORA), NLN};
          pg8::gemm_phase<pg8::EpiBf16, pg8::StaticOrder, true, true>(LDS_P, g, S, E); }
        GSYNC();
        { PHASE_IDS(); p3_chunked<1>(l, lds_g, WSP(const bf16, WS_P), WSP(const bf16, WS_LORA), ((bf16*)KOUT()), WSP(float, WS_ACT), tid, wave, lane); }
        GSYNC();
        { PHASE_IDS(); p3_chunked<2>(l, lds_g, WSP(const bf16, WS_P), WSP(const bf16, WS_LORA), ((bf16*)KOUT()), WSP(float, WS_ACT), tid, wave, lane); }
        GSYNC();
        { pg8::Gemm g{((const bf16*)KOUT()), WSP(const bf16, WS_W + (size_t)l * W_LAYER + WO_OUT), M, D, D}; pg8::StaticOrder S; S.init(M, D, (int)gridDim.x, (int)blockIdx.x);
          if (l == 0) { pg8::EpiRes<true> E{KIN(I_X), WSP(bf16, WS_XZ), WSP(const float, WS_MOD) + (size_t)l * BATCH * NMOD + 2048, ALPHA};
              pg8::gemm_phase<pg8::EpiRes<true>, pg8::StaticOrder, true, true>(LDS_P, g, S, E); }
          else { pg8::EpiRes<false> E{WSP(const bf16, WS_XZ), WSP(bf16, WS_XZ), WSP(const float, WS_MOD) + (size_t)l * BATCH * NMOD + 2048, ALPHA};
              pg8::gemm_phase<pg8::EpiRes<false>, pg8::StaticOrder, true, true>(LDS_P, g, S, E); } }
        GSYNC();
        { PHASE_IDS(); const float* modl = WSP(const float, WS_MOD) + (size_t)l * BATCH * NMOD;
          row_pass<true, true, true, 1>(WSP(const bf16, WS_XZ), WSP(bf16, WS_XZ), WSP(bf16, WS_H), KIN(I_LN1G) + (size_t)l * D, KIN(I_LN1B) + (size_t)l * D, modl + 3072, modl + 4096, gw, NGW, lane); }
        GSYNC();
        { pg8::Gemm g{WSP(const bf16, WS_H), WSP(const bf16, WS_W + (size_t)l * W_LAYER + WO_FI), M, 2 * DFF, D}; pg8::StaticOrder S; S.init(M, 2 * DFF, (int)gridDim.x, (int)blockIdx.x); pg8::EpiSwiGLU E{WSP(bf16, WS_P), DFF};
          pg8::gemm_phase<pg8::EpiSwiGLU, pg8::StaticOrder, true, true>(LDS_P, g, S, E); }
        GSYNC();
        { pg8::Gemm g{WSP(const bf16, WS_P), WSP(const bf16, WS_W + (size_t)l * W_LAYER + WO_FO), M, D, DFF}; pg8::StaticOrder S; S.init(M, D, (int)gridDim.x, (int)blockIdx.x);
          pg8::EpiRes<false> E{WSP(const bf16, WS_XZ), WSP(bf16, WS_XZ), WSP(const float, WS_MOD) + (size_t)l * BATCH * NMOD + 5120, ALPHA};
          pg8::gemm_phase<pg8::EpiRes<false>, pg8::StaticOrder, true, true>(LDS_P, g, S, E); }
        GSYNC();
        { PHASE_IDS();
          if (l + 1 < DEPTH) { const float* modn = WSP(const float, WS_MOD) + (size_t)(l + 1) * BATCH * NMOD;
              row_pass<true, true, true, 1>(WSP(const bf16, WS_XZ), WSP(bf16, WS_XZ), WSP(bf16, WS_H), KIN(I_LN2G) + (size_t)l * D, KIN(I_LN2B) + (size_t)l * D, modn + 0, modn + 1024, gw, NGW, lane); }
          else row_pass<true, false, true, 2>(WSP(const bf16, WS_XZ), KOUT(), nullptr, KIN(I_LN2G) + (size_t)l * D, KIN(I_LN2B) + (size_t)l * D, nullptr, nullptr, gw, NGW, lane); }
        if (l + 1 < DEPTH) GSYNC();
    }
}

extern "C" void kernel_launch(void* const* d_in, const int* in_sizes, int n_in, void* d_out, int out_size, void* d_ws, size_t ws_size, hipStream_t stream) {
    static int grid = 0;
    if (grid == 0) {
        if (n_in != 24 || out_size != M * D || ws_size < WS_END) { fprintf(stderr, "kernel_launch: unexpected problem (n_in %d out %d ws %zu)\n", n_in, out_size, ws_size); grid = -1; return; }
        int dev = 0, cus = 0, per_cu = 0;
        hipGetDevice(&dev); hipDeviceGetAttribute(&cus, hipDeviceAttributeMultiprocessorCount, dev);
        if (hipFuncSetAttribute((const void*)fwd_megakernel, hipFuncAttributeMaxDynamicSharedMemorySize, LDS_BYTES) != hipSuccess) { fprintf(stderr, "kernel_launch: hipFuncSetAttribute failed\n"); grid = -1; return; }
        if (hipOccupancyMaxActiveBlocksPerMultiprocessor(&per_cu, (const void*)fwd_megakernel, NTHR, LDS_BYTES) != hipSuccess || per_cu < 1) { fprintf(stderr, "kernel_launch: occupancy query says %d\n", per_cu); per_cu = 1; }
        (void)hipGetLastError();
        grid = cus;
        fprintf(stderr, "kernel_launch: grid %d (cus %d, per_cu %d)\n", grid, cus, per_cu);
    }
    if (grid < 0) return;
    if (hipMemsetAsync(d_ws, 0, 65536, stream) != hipSuccess) { fprintf(stderr, "kernel_launch: memset of the barrier words failed\n"); return; }
    Args a{};
    for (int i = 0; i < 24; ++i) a.in[i] = (const float*)d_in[i];
    a.out = (float*)d_out; a.ws = (unsigned char*)d_ws;
    void* args[] = {&a};
    hipError_t e = hipLaunchCooperativeKernel((const void*)fwd_megakernel, dim3(grid), dim3(NTHR), args, LDS_BYTES, stream);
    if (e != hipSuccess) fprintf(stderr, "kernel_launch: cooperative launch failed: %s\n", hipGetErrorString(e));
}
```
